# Optimizing an MI355X kernel written in HIP

```python
import math
import jax, jax.numpy as jnp
from jax import lax
import numpy as np

D_MODEL = 1024
BATCH = 8
SEQ = 8192
DEPTH = 1

CHUNK = 64
QBLOCK = 128
SPATIAL_CHUNK = 128
MIX_WIDTH = D_MODEL
MIX_GROUP_W = MIX_WIDTH // 2
SB_HEADS = 8
SB_HEAD_DIM = MIX_GROUP_W // SB_HEADS
SGU_GROUPS = 8
SGU_GROUP_DIM = MIX_GROUP_W // SGU_GROUPS
IN_PROJ_W = 5 * MIX_GROUP_W
D_FF = int(math.ceil((8 * D_MODEL / 3) / 256) * 256)
EPS = 1e-6

kernel_name = "hybrid_stickbreak_sgu_block"


def rms_norm(x, g):
    xf = x.astype(jnp.float32)
    y = xf * lax.rsqrt(jnp.mean(xf * xf, axis=-1, keepdims=True) + EPS)
    return (y * g.astype(jnp.float32)).astype(x.dtype)


def stick_breaking_attention(q, k, v):
    S = q.shape[1]
    dh = q.shape[-1]
    scale = dh ** -0.5
    n_blocks = S // QBLOCK
    outs = []
    for i in range(n_blocks):
        kv_len = (i + 1) * QBLOCK
        q_blk = q[:, i * QBLOCK:(i + 1) * QBLOCK]
        k_pre = k[:, :kv_len]
        v_pre = v[:, :kv_len]
        z = jnp.einsum('bqhd,bkhd->bhqk', q_blk, k_pre).astype(jnp.float32) * scale
        t_pos = i * QBLOCK + jnp.arange(QBLOCK)
        s_pos = jnp.arange(kv_len)
        strict = s_pos[None, :] < t_pos[:, None]
        log_fail = jnp.where(strict, jax.nn.log_sigmoid(-z), 0.0)
        after = lax.cumsum(log_fail, axis=3, reverse=True) - log_fail
        log_a = jax.nn.log_sigmoid(z) + after
        a = jnp.where(strict, jnp.exp(log_a), 0.0)
        outs.append(jnp.einsum('bhqk,bkhd->bqhd', a.astype(v.dtype), v_pre))
    return jnp.concatenate(outs, axis=1)


def chunk_causal_spatial_mask():
    pos = jnp.arange(SPATIAL_CHUNK)
    return (pos[None, :] // CHUNK) <= (pos[:, None] // CHUNK)


def spatial_gating(u, g, w_spatial, b_spatial):
    B, S, G, Dg = g.shape
    n = S // SPATIAL_CHUNK
    g_c = g.reshape(B, n, SPATIAL_CHUNK, G, Dg)
    w = jnp.where(chunk_causal_spatial_mask()[None], w_spatial, 0.0).astype(g.dtype)
    s = jnp.einsum('gij,bnjgd->bnigd', w, g_c) + b_spatial.T[None, None, :, :, None].astype(g.dtype)
    return u * s.reshape(B, S, G, Dg)


def setup_inputs(seed: int = 0) -> dict:
    key = jax.random.key(seed)
    ks = jax.random.split(key, 16)
    f32 = jnp.float32

    def nrm(k, shape, scale):
        return jax.random.normal(k, shape, f32) * scale

    return {
        "x": nrm(ks[0], (BATCH, SEQ, D_MODEL), 1.0),
        "attn_norm_g": 1.0 + nrm(ks[1], (D_MODEL,), 0.02),
        "w_in": nrm(ks[2], (D_MODEL, IN_PROJ_W), D_MODEL ** -0.5),
        "q_norm_g": 1.0 + nrm(ks[3], (SB_HEAD_DIM,), 0.02),
        "k_norm_g": 1.0 + nrm(ks[4], (SB_HEAD_DIM,), 0.02),
        "sgu_norm_g": 1.0 + nrm(ks[5], (MIX_GROUP_W,), 0.02),
        "w_spatial": nrm(ks[6], (SGU_GROUPS, SPATIAL_CHUNK, SPATIAL_CHUNK), SPATIAL_CHUNK ** -0.5),
        "b_spatial": nrm(ks[7], (SGU_GROUPS, SPATIAL_CHUNK), 0.02),
        "sb_out_norm_g": 1.0 + nrm(ks[8], (MIX_GROUP_W,), 0.02),
        "sgu_out_norm_g": 1.0 + nrm(ks[9], (MIX_GROUP_W,), 0.02),
        "w_out": nrm(ks[10], (MIX_WIDTH, D_MODEL), MIX_WIDTH ** -0.5),
        "ffn_norm_g": 1.0 + nrm(ks[11], (D_MODEL,), 0.02),
        "w_gate": nrm(ks[12], (D_MODEL, D_FF), D_MODEL ** -0.5),
        "w_up": nrm(ks[13], (D_MODEL, D_FF), D_MODEL ** -0.5),
        "w_down": nrm(ks[14], (D_FF, D_MODEL), D_FF ** -0.5),
    }


def reference(x, attn_norm_g, w_in, q_norm_g, k_norm_g, sgu_norm_g, w_spatial, b_spatial,
              sb_out_norm_g, sgu_out_norm_g, w_out, ffn_norm_g, w_gate, w_up, w_down):
    B, S, _ = x.shape
    for _layer in range(DEPTH):
        h = rms_norm(x, attn_norm_g)
        proj = jnp.einsum('bsd,de->bse', h, w_in)
        q, k, v, u, g = jnp.split(proj, 5, axis=-1)

        q = rms_norm(q.reshape(B, S, SB_HEADS, SB_HEAD_DIM), q_norm_g)
        k = rms_norm(k.reshape(B, S, SB_HEADS, SB_HEAD_DIM), k_norm_g)
        v = v.reshape(B, S, SB_HEADS, SB_HEAD_DIM)
        o_sb = stick_breaking_attention(q, k, v).reshape(B, S, MIX_GROUP_W)

        u = jax.nn.gelu(u)
        g = rms_norm(jax.nn.gelu(g), sgu_norm_g)
        o_sgu = spatial_gating(u.reshape(B, S, SGU_GROUPS, SGU_GROUP_DIM),
                               g.reshape(B, S, SGU_GROUPS, SGU_GROUP_DIM),
                               w_spatial, b_spatial).reshape(B, S, MIX_GROUP_W)

        mixed = jnp.concatenate([rms_norm(o_sb, sb_out_norm_g), rms_norm(o_sgu, sgu_out_norm_g)], axis=-1)
        x = x + jnp.einsum('bse,ed->bsd', mixed, w_out)

        h2 = rms_norm(x, ffn_norm_g)
        ff = jax.nn.silu(jnp.einsum('bsd,df->bsf', h2, w_gate)) * jnp.einsum('bsd,df->bsf', h2, w_up)
        x = x + jnp.einsum('bsf,fd->bsd', ff, w_down)
    return x
```

```cpp
#include <hip/hip_runtime.h>
#include <hip/hip_cooperative_groups.h>
#include <cstdio>
#include <cstdint>
namespace cg = cooperative_groups;
#define MK_N_LAUNCHES 1
namespace pg8 {
#define PG8_LAS __attribute__((address_space(3)))
typedef unsigned short bf16_t;
typedef short bf16x8 __attribute__((ext_vector_type(8)));
typedef float f32x4 __attribute__((ext_vector_type(4)));
typedef unsigned u32x4 __attribute__((ext_vector_type(4)));
constexpr int BM = 256, BK = 64, HALF = 128, HTB = HALF * BK * 2  , STAGE_BYTES = 8 * HTB, NXCD = 8, WGM = 8;

__host__ __device__ __forceinline__ int lds_byte(int r, int c) { const int st = (r >> 4) * 2 + (c >> 5), rr = r & 15, cc = c & 31, ob = rr * 64 + cc * 2; return st * 1024 + (ob ^ (((ob >> 9) & 1) << 5)); }
__host__ __device__ __forceinline__ void stage_rc(int b, int& R, int& C) { const int st = b / 1024, sb = b % 1024, swz = sb ^ (((sb >> 9) & 1) << 5); R = (st >> 1) * 16 + swz / 64; C = (st & 1) * 32 + (swz % 64) / 2; }
__host__ __device__ __forceinline__ int perm32(int rho) { const int n = rho >> 4, i = rho & 15; return 8 * (i >> 2) + 4 * n + (i & 3); }

struct Unit { int pm, pn; };
struct Gemm { const bf16_t* A; const bf16_t* Bt; int M, N, K; };

struct StaticOrder {
    int nM, nN, nwg, G, c;
    __host__ __device__ void init(int M, int N, int G_, int c_) { nM = M / BM; nN = N / BM; nwg = nM * nN; G = G_; c = c_; }
    __host__ __device__ bool next(int i, Unit& u) const {
        const long L = (long)i * G + c; if (L >= nwg) return false;
        int wgid = (int)L; { const int q = nwg / NXCD, r = nwg % NXCD, xcd = wgid % NXCD, off = wgid / NXCD; wgid = (xcd < r ? xcd * (q + 1) : r * (q + 1) + (xcd - r) * q) + off; }
        const int nig = WGM * nN, gid = wgid / nig, fm = gid * WGM, gsz = (nM - fm) < WGM ? (nM - fm) : WGM;
        u.pm = fm + ((wgid % nig) % gsz); u.pn = (wgid % nig) / gsz; return true;
    }
    __device__ __forceinline__ void a_ready(const Unit&) const {}
    __device__ __forceinline__ void done(const Unit&) const {}
};

__device__ __forceinline__ unsigned cvt_pk_bf16(float lo, float hi) { unsigned r; asm volatile("v_cvt_pk_bf16_f32 %0, %1, %2" : "=v"(r) : "v"(lo), "v"(hi)); return r; }
typedef float f32x2 __attribute__((ext_vector_type(2)));
constexpr int MTOK = 65536;
constexpr int VPITCH = MTOK + 2112;
constexpr float NORM_EPS = 1e-6f;
constexpr float QSCALE = 0.125f * 1.4426950408889634f;
__device__ __forceinline__ f32x4 exp2_4(const f32x4 t) { return (f32x4){__builtin_amdgcn_exp2f(t[0]), __builtin_amdgcn_exp2f(t[1]), __builtin_amdgcn_exp2f(t[2]), __builtin_amdgcn_exp2f(t[3])}; }
__device__ __forceinline__ f32x4 rcp_4(const f32x4 t) { return (f32x4){__builtin_amdgcn_rcpf(t[0]), __builtin_amdgcn_rcpf(t[1]), __builtin_amdgcn_rcpf(t[2]), __builtin_amdgcn_rcpf(t[3])}; }
__device__ __forceinline__ f32x4 gelu_tanh4(const f32x4 x) {
    const f32x4 x2 = x * x, p = x2 * (-0.10294324f) + (-2.3022082f), t = x * p;
    return x * rcp_4(exp2_4(t) + 1.0f);
}
typedef unsigned u32x2 __attribute__((ext_vector_type(2)));
__device__ __forceinline__ u32x4 pack8(const f32x4 a, const f32x4 b) { u32x4 w; w.x = cvt_pk_bf16(a[0], a[1]); w.y = cvt_pk_bf16(a[2], a[3]); w.z = cvt_pk_bf16(b[0], b[1]); w.w = cvt_pk_bf16(b[2], b[3]); return w; }
__device__ __forceinline__ float sumsq4(const f32x4 a) { return (a[0] * a[0] + a[1] * a[1]) + (a[2] * a[2] + a[3] * a[3]); }

struct OwnRows {
    int pm, nN;
    __device__ __forceinline__ bool next(int i, Unit& u) const { if (i >= nN) return false; int p = pm; asm volatile("" : "+s"(p));
        u.pm = p; u.pn = i; return true; }
    __device__ __forceinline__ void a_ready(const Unit&) const {}
    __device__ __forceinline__ void done(const Unit&) const {}
};

struct EpiTok1 {
    static constexpr bool PERM = true, AFTER_DRAIN = false;
    bf16_t* Q; size_t kind_stride; const float* rstd1; const float* qg; const float* kg;
    __device__ __forceinline__ void operator()(const f32x4 (&acc)[2][2][4][2], const Unit& u, int wr, int wc, int fr, int fq) const {
        const int kind = u.pn >> 1;
        bf16_t* base = Q + (size_t)kind * kind_stride;
        const int colb = (u.pn & 1) * 256 + wc * 64 + 8 * fq;
        const int row0 = u.pm * BM + wr * 64 + fr;
        f32x4 gv[2][2];
        if (kind < 2) { const float* gp = kind == 0 ? qg : kg; const float sc = kind == 0 ? QSCALE : 1.0f;
#pragma unroll
            for (int bj = 0; bj < 2; ++bj)
#pragma unroll
                for (int n = 0; n < 2; ++n) gv[bj][n] = *(const f32x4*)(gp + 32 * bj + 8 * fq + 4 * n) * sc;
        }
        float r1v[2][4];
#pragma unroll
        for (int ai = 0; ai < 2; ++ai)
#pragma unroll
            for (int m = 0; m < 4; ++m) r1v[ai][m] = rstd1[row0 + ai * HALF + m * 16];
#pragma unroll
        for (int ai = 0; ai < 2; ++ai)
#pragma unroll
            for (int m = 0; m < 4; ++m) {
                const int row = row0 + ai * HALF + m * 16;
                const float r1 = r1v[ai][m];
                f32x4 v[2][2];
#pragma unroll
                for (int bj = 0; bj < 2; ++bj)
#pragma unroll
                    for (int n = 0; n < 2; ++n) v[bj][n] = acc[ai][bj][m][n] * r1;
                if (kind < 2) {
                    float ss = (sumsq4(v[0][0]) + sumsq4(v[0][1])) + (sumsq4(v[1][0]) + sumsq4(v[1][1]));
                    ss += __shfl_xor(ss, 16); ss += __shfl_xor(ss, 32);
                    const float rn = __builtin_amdgcn_rsqf(ss * (1.0f / 64.0f) + NORM_EPS);
#pragma unroll
                    for (int bj = 0; bj < 2; ++bj)
#pragma unroll
                        for (int n = 0; n < 2; ++n) v[bj][n] = v[bj][n] * rn * gv[bj][n];
                } else {
#pragma unroll
                    for (int bj = 0; bj < 2; ++bj)
#pragma unroll
                        for (int n = 0; n < 2; ++n) v[bj][n] = gelu_tanh4(v[bj][n]);
                }
                const int hg = (u.pn & 1) * 4 + wc;
                if (kind < 2) {
                    bf16_t* kp = base + ((size_t)((row >> 5) * 8 + hg) * 4 * 64 + (row & 31) * 2 + (fq & 1)) * 8;
#pragma unroll
                    for (int bj = 0; bj < 2; ++bj) *(u32x4*)(kp + (size_t)(2 * bj + (fq >> 1)) * 512) = pack8(v[bj][0], v[bj][1]);
                } else {
#pragma unroll
                    for (int bj = 0; bj < 2; ++bj) { bf16_t* up = base + ((((size_t)((row >> 5) * 8 + hg) * 4 + 2 * bj + (fq >> 1)) * 64 + (row & 31) * 2) * 2 + (fq & 1)) * 4;
                        u32x2 w0, w1; w0.x = cvt_pk_bf16(v[bj][0][0], v[bj][0][1]); w0.y = cvt_pk_bf16(v[bj][0][2], v[bj][0][3]); w1.x = cvt_pk_bf16(v[bj][1][0], v[bj][1][1]); w1.y = cvt_pk_bf16(v[bj][1][2], v[bj][1][3]);
                        *(u32x2*)up = w0; *(u32x2*)(up + 8) = w1; }
                }
            }
    }
};

struct EpiCh1 {
    static constexpr bool PERM = true, AFTER_DRAIN = false;
    bf16_t* Vt; bf16_t* Gt; const float* rstd1; float* gss;
    __device__ __forceinline__ void operator()(const f32x4 (&acc)[2][2][4][2], const Unit& u, int wr, int wc, int fr, int fq) const {
        const int tok0 = u.pn * BM + wc * 32 + 8 * fq;
        f32x4 rs[2][2];
#pragma unroll
        for (int bj = 0; bj < 2; ++bj)
#pragma unroll
            for (int n = 0; n < 2; ++n) rs[bj][n] = *(const f32x4*)(rstd1 + tok0 + bj * HALF + 4 * n);
        const bool isg = u.pm >= 2;
        const int ch0 = (u.pm & 1) * 256 + wr * 64 + fr;
        f32x4 sq[2][2];
#pragma unroll
        for (int bj = 0; bj < 2; ++bj)
#pragma unroll
            for (int n = 0; n < 2; ++n) sq[bj][n] = (f32x4){0.f, 0.f, 0.f, 0.f};
#pragma unroll
        for (int ai = 0; ai < 2; ++ai)
#pragma unroll
            for (int m = 0; m < 4; ++m) {
#pragma unroll
                for (int bj = 0; bj < 2; ++bj) {
                    f32x4 v0 = acc[ai][bj][m][0] * rs[bj][0], v1 = acc[ai][bj][m][1] * rs[bj][1];
                    if (isg) {
                        v0 = gelu_tanh4(v0); v1 = gelu_tanh4(v1);
                        sq[bj][0] += v0 * v0; sq[bj][1] += v1 * v1;
                    }
                    if (isg) { const int ch = ch0 + ai * HALF + m * 16;
                        *(u32x4*)(Gt + (((((size_t)(u.pn * 2 + bj) * 8 + (ch >> 6)) * 2 + ((ch >> 5) & 1)) * 8 + 2 * wc + (fq >> 1)) * 64 + (ch & 31) * 2 + (fq & 1)) * 8) = pack8(v0, v1); }
                    else {
                        const int ch = ch0 + ai * HALF + m * 16, tb = u.pn * 8 + bj * 4 + wc;
                        bf16_t* vp = Vt + ((size_t)(((tb * 8 + (ch >> 6)) * 2 + ((ch >> 5) & 1)) * 2 + (fq >> 1)) * 64 + (ch & 31) * 2) * 8 + (fq & 1) * 4;
                        u32x2 w0, w1; w0.x = cvt_pk_bf16(v0[0], v0[1]); w0.y = cvt_pk_bf16(v0[2], v0[3]); w1.x = cvt_pk_bf16(v1[0], v1[1]); w1.y = cvt_pk_bf16(v1[2], v1[3]);
                        *(u32x2*)vp = w0; *(u32x2*)(vp + 8) = w1; }
                }
            }
        if (isg) {
#pragma unroll
            for (int bj = 0; bj < 2; ++bj)
#pragma unroll
                for (int n = 0; n < 2; ++n)
#pragma unroll
                    for (int e = 0; e < 4; ++e) { float s = sq[bj][n][e]; s += __shfl_xor(s, 1); s += __shfl_xor(s, 2); s += __shfl_xor(s, 4); s += __shfl_xor(s, 8); sq[bj][n][e] = s; }
            if (fr == 0) { float* gp = gss + (size_t)((u.pm - 2) * 2 + wr) * MTOK + tok0;
#pragma unroll
                for (int bj = 0; bj < 2; ++bj)
#pragma unroll
                    for (int n = 0; n < 2; ++n) *(f32x4*)(gp + bj * HALF + 4 * n) = sq[bj][n]; }
        }
    }
};

struct EpiOut {
    static constexpr bool PERM = true, AFTER_DRAIN = false;
    const bf16_t* xb; bf16_t* x1b; float* ss2; const PG8_LAS float* rbl;
    __device__ __forceinline__ void operator()(const f32x4 (&acc)[2][2][4][2], const Unit& u, int wr, int wc, int fr, int fq) const {
        const int col0 = u.pn * BM + wc * 32 + 8 * fq;
        const int row0 = u.pm * BM + wr * 64 + fr;
#pragma unroll
        for (int ai = 0; ai < 2; ++ai) {
            u32x4 xr[4][2]; float rbv[4];
#pragma unroll
            for (int m = 0; m < 4; ++m) { rbv[m] = rbl[wr * 64 + fr + ai * HALF + m * 16];
#pragma unroll
                for (int bj = 0; bj < 2; ++bj) xr[m][bj] = *(const u32x4*)(xb + (size_t)(row0 + ai * HALF + m * 16) * 1024 + col0 + bj * HALF); }
#pragma unroll
            for (int m = 0; m < 4; ++m) {
                const int row = row0 + ai * HALF + m * 16; const size_t off = (size_t)row * 1024 + col0;
                float ss = 0.f;
#pragma unroll
                for (int bj = 0; bj < 2; ++bj) { const u32x4 r = xr[m][bj];
                    const f32x4 x0 = {__uint_as_float(r.x << 16), __uint_as_float(r.x & 0xffff0000u), __uint_as_float(r.y << 16), __uint_as_float(r.y & 0xffff0000u)};
                    const f32x4 x1 = {__uint_as_float(r.z << 16), __uint_as_float(r.z & 0xffff0000u), __uint_as_float(r.w << 16), __uint_as_float(r.w & 0xffff0000u)};
                    const f32x4 v0 = acc[ai][bj][m][0] * rbv[m] + x0, v1 = acc[ai][bj][m][1] * rbv[m] + x1;
                    *(u32x4*)(x1b + off + bj * HALF) = pack8(v0, v1);
                    ss += sumsq4(v0) + sumsq4(v1);
                }
                ss += __shfl_xor(ss, 16); ss += __shfl_xor(ss, 32);
                if (fq == 0) ss2[(size_t)row * 16 + u.pn * 4 + wc] = ss;
            }
        }
    }
};

struct EpiGU {
    static constexpr bool PERM = true, AFTER_DRAIN = false;
    bf16_t* act; const float* rstd2; int ldc;
    __device__ __forceinline__ void operator()(const f32x4 (&acc)[2][2][4][2], const Unit& u, int wr, int wc, int fr, int fq) const {
        const int col0 = u.pn * HALF + wc * 32 + 8 * fq;
        const int row0 = u.pm * BM + wr * 64 + fr;
        float rv[2][4];
#pragma unroll
        for (int ai = 0; ai < 2; ++ai)
#pragma unroll
            for (int m = 0; m < 4; ++m) rv[ai][m] = rstd2[row0 + ai * HALF + m * 16];
#pragma unroll
        for (int ai = 0; ai < 2; ++ai)
#pragma unroll
            for (int m = 0; m < 4; ++m) {
                const int row = row0 + ai * HALF + m * 16;
                const float r = rv[ai][m], c1 = -1.4426950408889634f * r, r2 = r * r;
                f32x4 o[2];
#pragma unroll
                for (int n = 0; n < 2; ++n) { const f32x4 g = acc[ai][0][m][n], uu = acc[ai][1][m][n];
                    o[n] = (g * uu) * (rcp_4(exp2_4(g * c1) + 1.0f) * r2); }
                *(u32x4*)(act + (size_t)row * ldc + col0) = pack8(o[0], o[1]);
            }
    }
};
template <class Sched> __device__ __forceinline__ void gu_prepare_rstd(const Sched& S, const float* ss2, float* rstd2) {
    const int tid = threadIdx.x; Unit u; int last = -1;
    for (int i = 0; S.next(i, u); ++i) if (u.pm != last) { last = u.pm;
        const int row = u.pm * BM + (tid >> 1); const f32x4* sp = (const f32x4*)(ss2 + (size_t)row * 16) + (tid & 1) * 2;
        const f32x4 p = sp[0] + sp[1]; float s = (p[0] + p[1]) + (p[2] + p[3]); s += __shfl_xor(s, 1);
        if (!(tid & 1)) rstd2[row] = __builtin_amdgcn_rsqf(s * (1.0f / 1024.0f) + NORM_EPS); }
    asm volatile("s_waitcnt vmcnt(0)" ::: "memory"); __syncthreads();
}

struct EpiDown {
    static constexpr bool PERM = true, AFTER_DRAIN = false;
    const bf16_t* x1b; float* out;
    __device__ __forceinline__ void operator()(const f32x4 (&acc)[2][2][4][2], const Unit& u, int wr, int wc, int fr, int fq) const {
        const int col0 = u.pn * BM + wc * 32 + 8 * fq;
        const int row0 = u.pm * BM + wr * 64 + fr;
        u32x4 rr[2][4][2];
#pragma unroll
        for (int ai = 0; ai < 2; ++ai)
#pragma unroll
            for (int m = 0; m < 4; ++m)
#pragma unroll
                for (int bj = 0; bj < 2; ++bj) rr[ai][m][bj] = *(const u32x4*)(x1b + (size_t)(row0 + ai * HALF + m * 16) * 1024 + col0 + bj * HALF);
#pragma unroll
        for (int ai = 0; ai < 2; ++ai)
#pragma unroll
            for (int m = 0; m < 4; ++m) {
                const size_t off = (size_t)(row0 + ai * HALF + m * 16) * 1024 + col0;
#pragma unroll
                for (int bj = 0; bj < 2; ++bj) { const u32x4 r = rr[ai][m][bj];
                    const f32x4 r0 = {__uint_as_float(r.x << 16), __uint_as_float(r.x & 0xffff0000u), __uint_as_float(r.y << 16), __uint_as_float(r.y & 0xffff0000u)};
                    const f32x4 r1 = {__uint_as_float(r.z << 16), __uint_as_float(r.z & 0xffff0000u), __uint_as_float(r.w << 16), __uint_as_float(r.w & 0xffff0000u)};
                    *(f32x4*)(out + off + bj * HALF) = r0 + acc[ai][bj][m][0]; *(f32x4*)(out + off + bj * HALF + 4) = r1 + acc[ai][bj][m][1]; }
            }
    }
};
template <class Epi, class Sched, bool ALIGN_EPI = false, bool SP2 = false, bool MID = false>
__device__ __forceinline__ void gemm_phase(PG8_LAS unsigned char* lds, const Gemm g, const Sched& S, const Epi& E, const float* mid_scale = nullptr) {
    const int tid = threadIdx.x, wid = __builtin_amdgcn_readfirstlane(tid >> 6), lane = tid & 63, wr = wid >> 2, wc = wid & 3, fr = lane & 15, fq = lane >> 4;
    const int K = g.K, nt = K / BK;
    unsigned voffA[2], voffB[2];
#pragma unroll
    for (int i = 0; i < 2; ++i) { int R, C; stage_rc(tid * 16 + i * 8192, R, C); const int Rb = Epi::PERM ? ((R & ~31) + perm32(R & 31)) : R;
        voffA[i] = (unsigned)(R * K + C) * 2u; voffB[i] = (unsigned)(Rb * K + C) * 2u; }
    const size_t kstep = (size_t)(BK * 2);
    const size_t hstep = (size_t)HALF * K * 2;
    const size_t tstep = 2 * hstep;
    const unsigned ldsw = (unsigned)wid * 1024u;
    const int aoff = lds_byte(wr * 64 + fr, fq * 8), boff = lds_byte(wc * 32 + fr, fq * 8);
#define PG8_SA(b, h) (((b) * 2 + (h)) * HTB)
#define PG8_SB(b, h) ((4 + (b) * 2 + (h)) * HTB)
#define PG8_STAGE(bufoff, gbase, voff) do { _Pragma("unroll") for (int _i = 0; _i < 2; ++_i) \
        __builtin_amdgcn_global_load_lds((const unsigned*)((const char*)(gbase) + (voff)[_i]), (PG8_LAS unsigned*)(lds + (bufoff) + ldsw + _i * 8192), 16, 0, 0); } while (0)
#define PG8_LDA(dst, b, h) do { _Pragma("unroll") for (int m = 0; m < 4; ++m) _Pragma("unroll") for (int k = 0; k < 2; ++k) dst[m][k] = *(const PG8_LAS bf16x8*)(lds + PG8_SA(b, h) + aoff + m * 2048 + k * 1024); } while (0)
#define PG8_LDB(dst, b, h) do { _Pragma("unroll") for (int n = 0; n < 2; ++n) _Pragma("unroll") for (int k = 0; k < 2; ++k) dst[n][k] = *(const PG8_LAS bf16x8*)(lds + PG8_SB(b, h) + boff + n * 2048 + k * 1024); } while (0)
#define PG8_MMA(ai, bj, At, Bt) do { __builtin_amdgcn_s_setprio(1); _Pragma("unroll") for (int m = 0; m < 4; ++m) _Pragma("unroll") for (int n = 0; n < 2; ++n) _Pragma("unroll") for (int k = 0; k < 2; ++k) \
        acc[ai][bj][m][n] = __builtin_amdgcn_mfma_f32_16x16x32_bf16(Bt[n][k], At[m][k], acc[ai][bj][m][n], 0, 0, 0); __builtin_amdgcn_s_setprio(0); } while (0)
#define PG8_WAIT_V(n) asm volatile("s_waitcnt vmcnt(" #n ")" ::: "memory")
#define PG8_WAIT_L(n) asm volatile("s_waitcnt lgkmcnt(" #n ")" ::: "memory")
#define PG8_BAR __builtin_amdgcn_s_barrier()
#define PG8_SCHED __builtin_amdgcn_sched_barrier(0)
    Unit cur, nxt; int ui = 0;
    if (!S.next(0, cur)) return;
    f32x4 acc[2][2][4][2];
#pragma unroll
    for (int a = 0; a < 2; ++a)
#pragma unroll
        for (int b = 0; b < 2; ++b)
#pragma unroll
            for (int m = 0; m < 4; ++m)
#pragma unroll
                for (int n = 0; n < 2; ++n) acc[a][b][m][n] = (f32x4){0.f, 0.f, 0.f, 0.f};
    bf16x8 At[4][2], B0[2][2], B1[2][2];
    const char* cA = (const char*)g.A + (size_t)cur.pm * tstep; const char* cB = (const char*)g.Bt + (size_t)cur.pn * tstep;
    S.a_ready(cur);
    if constexpr (SP2) {
        PG8_STAGE(PG8_SB(0, 0), cB, voffB); PG8_STAGE(PG8_SB(0, 1), cB + hstep, voffB); PG8_STAGE(PG8_SA(0, 0), cA, voffA); PG8_STAGE(PG8_SA(0, 1), cA + hstep, voffA);
        if (wr == 1) PG8_BAR;
        PG8_WAIT_V(2); PG8_BAR;
        PG8_STAGE(PG8_SB(1, 0), cB + kstep, voffB); PG8_STAGE(PG8_SA(1, 0), cA + kstep, voffA); PG8_STAGE(PG8_SB(1, 1), cB + hstep + kstep, voffB);
        PG8_WAIT_V(6); PG8_BAR;
    } else {
        PG8_STAGE(PG8_SB(0, 0), cB, voffB); PG8_STAGE(PG8_SA(0, 0), cA, voffA); PG8_STAGE(PG8_SB(0, 1), cB + hstep, voffB); PG8_STAGE(PG8_SA(0, 1), cA + hstep, voffA);
        if (wr == 1) PG8_BAR;
        PG8_WAIT_V(4); PG8_BAR;
        PG8_STAGE(PG8_SB(1, 0), cB + kstep, voffB); PG8_STAGE(PG8_SA(1, 0), cA + kstep, voffA); PG8_STAGE(PG8_SB(1, 1), cB + hstep + kstep, voffB);
        PG8_WAIT_V(6); PG8_BAR;
    }
    for (;;) {
        const bool has_next = S.next(ui + 1, nxt);
        const char* nA = has_next ? (const char*)g.A + (size_t)nxt.pm * tstep : cA; const char* nB = has_next ? (const char*)g.Bt + (size_t)nxt.pn * tstep : cB;
        for (int t = 0; t < nt; t += 2) {
            const bool last = (t == nt - 2);
            if constexpr (MID) {
                PG8_LAS float* midl = (PG8_LAS float*)(lds + STAGE_BYTES + 2048);
                if (t == (nt >> 1) - 2) { if (tid < 256) { const f32x2 ms = *(const f32x2*)(mid_scale + 2 * (cur.pm * BM + tid)); midl[tid] = ms.x; midl[256 + tid] = ms.y; } }
                if (t == (nt >> 1)) { const PG8_LAS float* mp_ = midl + wr * 64 + fr;
#pragma unroll
                    for (int a_ = 0; a_ < 2; ++a_)
#pragma unroll
                        for (int m_ = 0; m_ < 4; ++m_) { const float rr = mp_[a_ * HALF + m_ * 16];
#pragma unroll
                            for (int b_ = 0; b_ < 2; ++b_)
#pragma unroll
                                for (int n_ = 0; n_ < 2; ++n_) acc[a_][b_][m_][n_] = acc[a_][b_][m_][n_] * rr; } } }
            const char* a1 = cA + (size_t)(t + 1) * kstep;
            const char* a2 = last ? nA : cA + (size_t)(t + 2) * kstep; const char* b2 = last ? nB : cB + (size_t)(t + 2) * kstep;
            const char* a3 = a2 + kstep; const char* b3 = b2 + kstep;
            if (last && has_next) S.a_ready(nxt);
            if constexpr (SP2) {
            PG8_LDB(B0, 0, 0); PG8_LDB(B1, 0, 1); PG8_SCHED; PG8_LDA(At, 0, 0); PG8_STAGE(PG8_SA(1, 1), a1 + hstep, voffA);
            PG8_WAIT_V(8); PG8_WAIT_L(0); PG8_BAR; PG8_MMA(0, 0, At, B0); PG8_MMA(0, 1, At, B1); PG8_BAR; PG8_SCHED;
            PG8_LDA(At, 0, 1); PG8_STAGE(PG8_SB(0, 0), b2, voffB); PG8_STAGE(PG8_SB(0, 1), b2 + hstep, voffB); PG8_STAGE(PG8_SA(0, 0), a2, voffA);
            PG8_WAIT_V(8); PG8_WAIT_L(0); PG8_BAR; PG8_MMA(1, 0, At, B0); PG8_MMA(1, 1, At, B1); PG8_BAR; PG8_SCHED;
            PG8_LDB(B0, 1, 0); PG8_LDB(B1, 1, 1); PG8_SCHED; PG8_LDA(At, 1, 0); PG8_STAGE(PG8_SA(0, 1), a2 + hstep, voffA);
            PG8_WAIT_V(8); PG8_WAIT_L(0); PG8_BAR; PG8_MMA(0, 0, At, B0); PG8_MMA(0, 1, At, B1); PG8_BAR; PG8_SCHED;
            PG8_LDA(At, 1, 1); PG8_STAGE(PG8_SB(1, 0), b3, voffB); PG8_STAGE(PG8_SB(1, 1), b3 + hstep, voffB); PG8_STAGE(PG8_SA(1, 0), a3, voffA);
            PG8_WAIT_V(8); PG8_WAIT_L(0); PG8_BAR; PG8_MMA(1, 0, At, B0); PG8_MMA(1, 1, At, B1); PG8_BAR; PG8_SCHED;
            } else {
            PG8_LDB(B0, 0, 0); PG8_SCHED; PG8_LDA(At, 0, 0); PG8_STAGE(PG8_SA(1, 1), a1 + hstep, voffA);
            PG8_WAIT_L(8); PG8_BAR; PG8_WAIT_L(0); PG8_MMA(0, 0, At, B0); PG8_BAR; PG8_SCHED;
            PG8_LDB(B1, 0, 1); PG8_STAGE(PG8_SB(0, 0), b2, voffB);
            PG8_BAR; PG8_WAIT_L(0); PG8_MMA(0, 1, At, B1); PG8_BAR;
            PG8_LDA(At, 0, 1); PG8_STAGE(PG8_SA(0, 0), a2, voffA);
            PG8_BAR; PG8_WAIT_L(0); PG8_MMA(1, 0, At, B0); PG8_BAR; PG8_SCHED;
            PG8_STAGE(PG8_SB(0, 1), b2 + hstep, voffB);
            PG8_WAIT_V(6); PG8_BAR; PG8_MMA(1, 1, At, B1); PG8_BAR;
            PG8_LDB(B0, 1, 0); PG8_SCHED; PG8_LDA(At, 1, 0); PG8_STAGE(PG8_SA(0, 1), a2 + hstep, voffA);
            PG8_WAIT_L(8); PG8_BAR; PG8_WAIT_L(0); PG8_MMA(0, 0, At, B0); PG8_BAR; PG8_SCHED;
            PG8_LDB(B1, 1, 1); PG8_STAGE(PG8_SB(1, 0), b3, voffB);
            PG8_BAR; PG8_WAIT_L(0); PG8_MMA(0, 1, At, B1); PG8_BAR;
            PG8_LDA(At, 1, 1); PG8_STAGE(PG8_SA(1, 0), a3, voffA);
            PG8_BAR; PG8_WAIT_L(0); PG8_MMA(1, 0, At, B0); PG8_BAR; PG8_SCHED;
            PG8_STAGE(PG8_SB(1, 1), b3 + hstep, voffB);
            PG8_WAIT_V(6); PG8_BAR; PG8_MMA(1, 1, At, B1); PG8_BAR;
            }
        }
        if constexpr (ALIGN_EPI) { if (wr == 0) PG8_BAR; }
        if constexpr (!Epi::AFTER_DRAIN) { E(acc, cur, wr, wc, fr, fq); S.done(cur); }
        if (!has_next) break;
#pragma unroll
        for (int a = 0; a < 2; ++a)
#pragma unroll
            for (int b = 0; b < 2; ++b)
#pragma unroll
                for (int m = 0; m < 4; ++m)
#pragma unroll
                    for (int n = 0; n < 2; ++n) acc[a][b][m][n] = (f32x4){0.f, 0.f, 0.f, 0.f};
        cur = nxt; cA = nA; cB = nB; ++ui;
        if constexpr (ALIGN_EPI) { if (wr == 1) PG8_BAR; }
    }
    PG8_WAIT_V(0);
    if constexpr (!ALIGN_EPI) { if (wr == 0) PG8_BAR; }
    PG8_BAR;
    if constexpr (Epi::AFTER_DRAIN) { E.fused(acc, cur, wr, wc, fr, fq, lds, wid, lane); S.done(cur); }
#undef PG8_SA
#undef PG8_SB
#undef PG8_STAGE
#undef PG8_LDA
#undef PG8_LDB
#undef PG8_MMA
#undef PG8_WAIT_V
#undef PG8_WAIT_L
#undef PG8_BAR
#undef PG8_SCHED
}
}

namespace mixp {
using pg8::bf16_t; using pg8::bf16x8; using pg8::f32x4; using pg8::u32x4; using pg8::MTOK; using pg8::VPITCH; using pg8::NORM_EPS;
typedef float f32x16 __attribute__((ext_vector_type(16)));
typedef short s16x4 __attribute__((ext_vector_type(4)));
typedef unsigned u32x2 __attribute__((ext_vector_type(2)));
typedef float f32x2_t __attribute__((ext_vector_type(2))); typedef __bf16 bf16x2_t __attribute__((ext_vector_type(2)));
#define MX_LAS __attribute__((address_space(3)))
#define MFMA32(a, b, c) __builtin_amdgcn_mfma_f32_32x32x16_bf16((a), (b), (c), 0, 0, 0)
__device__ __forceinline__ unsigned cvtpk(float lo, float hi) { f32x2_t v = {lo, hi}; bf16x2_t b = __builtin_convertvector(v, bf16x2_t); return __builtin_bit_cast(unsigned, b); }
__device__ __forceinline__ float bf2f(short s) { return __uint_as_float(((unsigned)(unsigned short)s) << 16); }
__device__ __forceinline__ float half_sum(float v) { auto rr = __builtin_amdgcn_permlane32_swap(__float_as_uint(v), __float_as_uint(v), false, false); return __uint_as_float(rr[0]) + __uint_as_float(rr[1]); }

struct MixArgs { const bf16_t *Q, *K, *U, *Vt, *Gt, *Wsb; const float *gss, *bsp, *sgn, *gA, *gB; bf16_t* mixed; float* rowsc; };

__device__ __forceinline__ void mix_phase(MX_LAS unsigned char* lds, const MixArgs& a, int u_begin, int u_end) {
    const int tid = threadIdx.x, lane = tid & 63, l32 = lane & 31, hi = lane >> 5;
    const int w = __builtin_amdgcn_readfirstlane(tid >> 6);
    MX_LAS bf16x8* gnl = (MX_LAS bf16x8*)(lds + w * 16384) + lane;
    MX_LAS float* rgs = (MX_LAS float*)(lds + 131072 + 512);
    MX_LAS float* rtab = (MX_LAS float*)(lds + 131072 + 1024);
    MX_LAS float* part = (MX_LAS float*)(lds + 131072 + 2048);
    MX_LAS float* gtab = (MX_LAS float*)(lds + 131072 + 10240);
    const f32x16 zero16 = {0.f, 0.f, 0.f, 0.f, 0.f, 0.f, 0.f, 0.f, 0.f, 0.f, 0.f, 0.f, 0.f, 0.f, 0.f, 0.f};
    const float ninf = -__builtin_inff();
    { gtab[tid] = a.gA[tid]; gtab[512 + tid] = a.gB[tid]; }
    const MX_LAS float* gl = gtab + 64 * w + 4 * hi;
    for (int unit = u_begin; unit < u_end; ++unit) {
        const int tok0 = unit * 128;
        const int s0 = (unit & 63) * 128;
        const size_t seq0 = (size_t)(unit >> 6) * 8192;
        if (tid < 128) { const int t = tok0 + tid; const float s = (a.gss[t] + a.gss[MTOK + t]) + (a.gss[2 * MTOK + t] + a.gss[3 * MTOK + t]); rgs[tid] = __builtin_amdgcn_rsqf(s * (1.0f / 512.0f) + NORM_EPS); }
        __syncthreads();
#pragma unroll
        for (int cb = 0; cb < 2; ++cb) { const int c = 64 * w + 32 * cb + l32; const float sg = a.sgn[c]; const bf16_t* gp = a.Gt + (((size_t)unit * 8 + w) * 2 + cb) * 8 * 512 + (l32 * 2 + hi) * 8;
            bf16x8 raw[8];
#pragma unroll
            for (int kk = 0; kk < 8; ++kk) raw[kk] = *(const bf16x8*)(gp + kk * 512);
#pragma unroll
            for (int kk = 0; kk < 8; ++kk) {
                const f32x4 r0 = *(const MX_LAS f32x4*)(rgs + 16 * kk + 8 * hi) * sg, r1 = *(const MX_LAS f32x4*)(rgs + 16 * kk + 8 * hi + 4) * sg;
                u32x4 pk; pk.x = cvtpk(bf2f(raw[kk][0]) * r0[0], bf2f(raw[kk][1]) * r0[1]); pk.y = cvtpk(bf2f(raw[kk][2]) * r0[2], bf2f(raw[kk][3]) * r0[3]);
                pk.z = cvtpk(bf2f(raw[kk][4]) * r1[0], bf2f(raw[kk][5]) * r1[1]); pk.w = cvtpk(bf2f(raw[kk][6]) * r1[2], bf2f(raw[kk][7]) * r1[3]);
                gnl[(cb * 8 + kk) * 64] = __builtin_bit_cast(bf16x8, pk); } }
#define MX_STORE2(X, GP, COFF) do { _Pragma("unroll") for (int k = 0; k < 4; k += 2) { \
                const f32x4 g0 = *(const MX_LAS f32x4*)((GP) + 8 * k), g1 = *(const MX_LAS f32x4*)((GP) + 8 * k + 8); \
                unsigned ax = cvtpk(X[4 * k] * g0[0], X[4 * k + 1] * g0[1]), ay = cvtpk(X[4 * k + 2] * g0[2], X[4 * k + 3] * g0[3]); \
                unsigned bx_ = cvtpk(X[4 * k + 4] * g1[0], X[4 * k + 5] * g1[1]), by_ = cvtpk(X[4 * k + 6] * g1[2], X[4 * k + 7] * g1[3]); \
                auto rx = __builtin_amdgcn_permlane32_swap(ax, bx_, false, false); auto ry = __builtin_amdgcn_permlane32_swap(ay, by_, false, false); \
                u32x4 v; v.x = rx[0]; v.y = ry[0]; v.z = rx[1]; v.w = ry[1]; \
                *(u32x4*)(mp + (COFF) + 8 * k) = v; } } while (0)
        {
            bf16x8 wX[8], wY[8]; s16x4 uX0[4], uX1[4], uY0[4], uY1[4]; float bX, bY;
#define MX_SG_LOAD(ib_, W_, U0_, U1_, B_) do { \
                const bf16_t* wp = a.Wsb + (size_t)(w * 4 + (ib_)) * 8 * 512 + (l32 * 2 + hi) * 8; _Pragma("unroll") for (int kk = 0; kk < 8; ++kk) W_[kk] = *(const bf16x8*)(wp + kk * 512); \
                const bf16_t* up = a.U + ((size_t)((tok0 >> 5) + (ib_)) * 8 + w) * 4 * 512 + (l32 * 2 + hi) * 8; \
                _Pragma("unroll") for (int q = 0; q < 2; ++q) { const bf16x8 ua = *(const bf16x8*)(up + q * 512), ub = *(const bf16x8*)(up + (2 + q) * 512); \
                    U0_[2 * q] = __builtin_shufflevector(ua, ua, 0, 1, 2, 3); U0_[2 * q + 1] = __builtin_shufflevector(ua, ua, 4, 5, 6, 7); U1_[2 * q] = __builtin_shufflevector(ub, ub, 0, 1, 2, 3); U1_[2 * q + 1] = __builtin_shufflevector(ub, ub, 4, 5, 6, 7); } \
                B_ = a.bsp[w * 128 + 32 * (ib_) + l32]; } while (0)
#define MX_SG_RUN(ib_, W_, U0_, U1_, B_) do { f32x16 sg0 = zero16, sg1 = zero16; \
                _Pragma("unroll") for (int kk = 0; kk < 8; ++kk) { sg0 = MFMA32(gnl[kk * 64], W_[kk], sg0); sg1 = MFMA32(gnl[(8 + kk) * 64], W_[kk], sg1); }     \
                float pb = 0.f; \
                _Pragma("unroll") for (int g4 = 0; g4 < 4; ++g4) _Pragma("unroll") for (int e = 0; e < 4; ++e) { \
                    sg0[4 * g4 + e] = bf2f(U0_[g4][e]) * (sg0[4 * g4 + e] + B_); sg1[4 * g4 + e] = bf2f(U1_[g4][e]) * (sg1[4 * g4 + e] + B_); \
                    pb += sg0[4 * g4 + e] * sg0[4 * g4 + e] + sg1[4 * g4 + e] * sg1[4 * g4 + e]; } \
                pb = half_sum(pb); if (hi == 0) part[(32 * (ib_) + l32) * 16 + 8 + w] = pb; \
                bf16_t* mp = a.mixed + (size_t)(tok0 + 32 * (ib_) + l32) * 1024 + 64 * w + 8 * hi; \
                MX_STORE2(sg0, (gl + 512), 512); MX_STORE2(sg1, (gl + 512 + 32), 512 + 32); } while (0)
            MX_SG_LOAD(0, wX, uX0, uX1, bX); MX_SG_LOAD(1, wY, uY0, uY1, bY);
            MX_SG_RUN(0, wX, uX0, uX1, bX); MX_SG_LOAD(2, wX, uX0, uX1, bX);
            MX_SG_RUN(1, wY, uY0, uY1, bY); MX_SG_LOAD(3, wY, uY0, uY1, bY);
            MX_SG_RUN(2, wX, uX0, uX1, bX);
            MX_SG_RUN(3, wY, uY0, uY1, bY);
#undef MX_SG_LOAD
#undef MX_SG_RUN
        }
        const bf16_t* Kw = a.K + (size_t)w * 4 * 512 + (l32 * 2 + hi) * 8;
        const bf16_t* vrow = a.Vt + (size_t)w * 4 * 512 + (l32 * 2 + hi) * 8;
#define MX_LOADKV(kf, va, k0_) do { const int kc_ = (k0_) < 0 ? 0 : (k0_); const size_t tb_ = ((seq0 + (size_t)kc_) >> 5) * 16384; const bf16_t* kp_ = Kw + tb_; const bf16_t* vp_ = vrow + tb_; \
            _Pragma("unroll") for (int kk = 0; kk < 4; ++kk) kf[kk] = *(const bf16x8*)(kp_ + kk * 512); \
            _Pragma("unroll") for (int db = 0; db < 2; ++db) _Pragma("unroll") for (int s = 0; s < 2; ++s) va[db][s] = *(const bf16x8*)(vp_ + (2 * db + s) * 512); } while (0)
#define MX_VF(va, db, s) va[db][s]
#define MX_TILE(kf, va, DIAG) do { \
            f32x16 S = zero16; \
            _Pragma("unroll") for (int kk = 0; kk < 4; ++kk) S = MFMA32(kf[kk], qf[kk], S); \
            f32x4 f4[4], be4[4];                                    \
            _Pragma("unroll") for (int g = 0; g < 4; ++g) { \
                const f32x4 sv = {__builtin_amdgcn_fmed3f(S[4 * g], ninf, 126.f), __builtin_amdgcn_fmed3f(S[4 * g + 1], ninf, 126.f), __builtin_amdgcn_fmed3f(S[4 * g + 2], ninf, 126.f), __builtin_amdgcn_fmed3f(S[4 * g + 3], ninf, 126.f)}; \
                const f32x4 e4 = pg8::exp2_4(sv); f4[g] = pg8::rcp_4(e4 + 1.0f); be4[g] = e4 * f4[g]; } \
            if (DIAG) { _Pragma("unroll") for (int g = 0; g < 4; ++g) _Pragma("unroll") for (int e = 0; e < 4; ++e) { const int key = e + 8 * g + 4 * hi; if (key >= l32) { f4[g][e] = 1.f; be4[g][e] = 0.f; } } } \
            f32x4 c4[4]; float T[4]; \
            _Pragma("unroll") for (int g = 0; g < 4; ++g) { const float p2 = f4[g][3], p1 = p2 * f4[g][2], p0 = p1 * f4[g][1]; T[g] = p0 * f4[g][0]; c4[g] = (f32x4){p0, p1, p2, 1.f}; } \
            float Ta[4], Tb[4]; \
            _Pragma("unroll") for (int g = 0; g < 4; ++g) { auto rr = __builtin_amdgcn_permlane32_swap(__float_as_uint(T[g]), __float_as_uint(T[g]), false, false); Ta[g] = __uint_as_float(rr[0]); Tb[g] = __uint_as_float(rr[1]); } \
            const float E6 = Tb[3], E5 = E6 * Ta[3], E4 = E5 * Tb[2], E3 = E4 * Ta[2], E2 = E3 * Tb[1], E1 = E2 * Ta[1], E0 = E1 * Tb[0], total = E0 * Ta[0]; \
            float Eg[4]; Eg[0] = hi ? E1 : E0; Eg[1] = hi ? E3 : E2; Eg[2] = hi ? E5 : E4; Eg[3] = hi ? 1.f : E6; \
            f32x4 A4[4]; \
            _Pragma("unroll") for (int g = 0; g < 4; ++g) A4[g] = be4[g] * (c4[g] * (carry * Eg[g])); \
            carry *= total; \
            u32x4 w0, w1; \
            w0.x = cvtpk(A4[0][0], A4[0][1]); w0.y = cvtpk(A4[0][2], A4[0][3]); w0.z = cvtpk(A4[1][0], A4[1][1]); w0.w = cvtpk(A4[1][2], A4[1][3]); \
            w1.x = cvtpk(A4[2][0], A4[2][1]); w1.y = cvtpk(A4[2][2], A4[2][3]); w1.z = cvtpk(A4[3][0], A4[3][1]); w1.w = cvtpk(A4[3][2], A4[3][3]); \
            const bf16x8 ps0 = __builtin_bit_cast(bf16x8, w0), ps1 = __builtin_bit_cast(bf16x8, w1); \
            o0 = MFMA32(MX_VF(va, 0, 0), ps0, o0); o0 = MFMA32(MX_VF(va, 0, 1), ps1, o0); \
            o1 = MFMA32(MX_VF(va, 1, 0), ps0, o1); o1 = MFMA32(MX_VF(va, 1, 1), ps1, o1); } while (0)
        bf16x8 qf[4], kfA[4], kfB[4], kfC[4], vaA[2][2], vaB[2][2], vaC[2][2];
#define MX_PRELOAD(ib_) do { const int q0_ = s0 + 32 * (ib_); \
            { const bf16_t* qp = a.Q + ((seq0 + (size_t)q0_) >> 5) * 16384 + (size_t)w * 4 * 512 + (l32 * 2 + hi) * 8; _Pragma("unroll") for (int kk = 0; kk < 4; ++kk) qf[kk] = *(const bf16x8*)(qp + kk * 512); } \
            MX_LOADKV(kfA, vaA, q0_); MX_LOADKV(kfB, vaB, q0_ - 32); } while (0)
        MX_PRELOAD(0);
#pragma unroll 1
        for (int ib = 0; ib < 4; ++ib) {
            const int q0 = s0 + 32 * ib;
            f32x16 o0 = zero16, o1 = zero16;
            {
                float carry = 1.f; int k0 = q0;
                for (;;) {
                    MX_LOADKV(kfC, vaC, k0 - 64);
                    MX_TILE(kfA, vaA, k0 == q0);
                    if (k0 < 32 || !__any(carry >= 1e-37f)) break;
                    k0 -= 32;
                    MX_LOADKV(kfA, vaA, k0 - 64);
                    MX_TILE(kfB, vaB, false);
                    if (k0 < 32 || !__any(carry >= 1e-37f)) break;
                    k0 -= 32;
                    MX_LOADKV(kfB, vaB, k0 - 64);
                    MX_TILE(kfC, vaC, false);
                    if (k0 < 32 || !__any(carry >= 1e-37f)) break;
                    k0 -= 32;
                }
            }
            float pa = 0.f;
#pragma unroll
            for (int r = 0; r < 16; ++r) pa += o0[r] * o0[r] + o1[r] * o1[r];
            pa = half_sum(pa); if (hi == 0) part[(32 * ib + l32) * 16 + w] = pa;
            if (ib < 3) MX_PRELOAD(ib + 1);
            bf16_t* mp = a.mixed + (size_t)(tok0 + 32 * ib + l32) * 1024 + 64 * w + 8 * hi;
            MX_STORE2(o0, gl, 0); MX_STORE2(o1, (gl + 32), 32);
        }
#undef MX_STORE2
#undef MX_LOADKV
#undef MX_PRELOAD
#undef MX_VF
#undef MX_TILE
        __syncthreads();
        if (tid < 128) { const MX_LAS f32x4* pp = (const MX_LAS f32x4*)(part + tid * 16); const f32x4 pa4 = pp[0] + pp[1], pb4 = pp[2] + pp[3];
            const float rA = __builtin_amdgcn_rsqf(((pa4[0] + pa4[1]) + (pa4[2] + pa4[3])) * (1.0f / 512.0f) + NORM_EPS), rB = __builtin_amdgcn_rsqf(((pb4[0] + pb4[1]) + (pb4[2] + pb4[3])) * (1.0f / 512.0f) + NORM_EPS);
            f32x2_t o; o.x = rA / rB; o.y = rB; *(f32x2_t*)(a.rowsc + (size_t)(tok0 + tid) * 2) = o; }
    }
}
#undef MFMA32
}

#ifndef MK_N_LAUNCHES
#define MK_N_LAUNCHES 1
#endif
constexpr int NWAVES = 8;
constexpr int MTOK = pg8::MTOK, DM = 1024, NTOK1 = 1536, NCH1 = 1024, DFF = 2816, NGU = 2 * DFF;
constexpr size_t MiB = 1u << 20;
constexpr size_t WS_WTOK = 2 * MiB, WS_WCH = 5 * MiB, WS_WOUT = 7 * MiB, WS_WGU = 9 * MiB, WS_WDN = 20 * MiB, WS_WSB = 26 * MiB, WS_RSTD1 = 27 * MiB, WS_RSTD2 = 27 * MiB + 512 * 1024, WS_GSS = 28 * MiB, WS_SS2 = 29 * MiB, WS_ROWSC = 33 * MiB;
constexpr size_t WS_XB = 64 * MiB, WS_Q = 192 * MiB, WS_K = 256 * MiB, WS_U = 320 * MiB, WS_VT = 384 * MiB, WS_GT = 452 * MiB, WS_MIXED = 520 * MiB, WS_X1B = 648 * MiB, WS_END = 776 * MiB;
constexpr size_t WS_ACT = 64 * MiB;
static_assert(WS_K - WS_Q == WS_U - WS_K, "q | k | u outputs equally spaced");
static_assert(WS_VT + (size_t)512 * pg8::VPITCH * 2 <= WS_GT && WS_GT + (size_t)512 * pg8::VPITCH * 2 <= WS_MIXED, "V^T / G^T slots");
static_assert(WS_WGU + (size_t)NGU * DM * 2 <= WS_WDN && WS_WDN + (size_t)DM * DFF * 2 <= WS_WSB && WS_SS2 + (size_t)MTOK * 64 <= WS_XB && WS_ACT + (size_t)MTOK * DFF * 2 <= WS_MIXED, "d_ws map");
constexpr int RING_BYTES = 131072;
constexpr int LDS_BYTES = 147456;

#define GAS __attribute__((address_space(1)))
#define LAS __attribute__((address_space(3)))
typedef unsigned short bf16;
typedef unsigned v4u __attribute__((ext_vector_type(4)));
typedef float f32x4 __attribute__((ext_vector_type(4)));
#define LDS_WAIT() asm volatile("s_waitcnt lgkmcnt(0)" ::: "memory")
__device__ __forceinline__ unsigned f2bf(float f) { unsigned u = __builtin_bit_cast(unsigned, f); return (u + 0x7fffu + ((u >> 16) & 1u)) >> 16; }
__device__ __forceinline__ unsigned pk2(float lo, float hi) { return f2bf(lo) | (f2bf(hi) << 16); }
__device__ __forceinline__ float wave_sum(float v) {
#pragma unroll
    for (int o = 1; o < 64; o <<= 1) v += __shfl_xor(v, o);
    return v;
}
__device__ __forceinline__ void tr_item(const float* W, int ldw, int k0, int n_src0, const float* scale, bf16* WT, int ldt, int n_dst0, LAS float* scr, int lane) {
#pragma unroll 8
    for (int i = 0; i < 32; ++i) { const int kk = 2 * i + (lane >> 5); const float s = scale ? scale[k0 + kk] : 1.0f; scr[kk * 33 + (lane & 31)] = W[(size_t)(k0 + kk) * ldw + n_src0 + (lane & 31)] * s; }
    LDS_WAIT(); asm volatile("" ::: "memory");
    const int c = lane & 7;
#pragma unroll
    for (int j = 0; j < 4; ++j) { const int n = (lane >> 3) + 8 * j; const LAS float* s = scr + (8 * c) * 33 + n;
        v4u o; o.x = pk2(s[0 * 33], s[1 * 33]); o.y = pk2(s[2 * 33], s[3 * 33]); o.z = pk2(s[4 * 33], s[5 * 33]); o.w = pk2(s[6 * 33], s[7 * 33]);
        *(v4u*)(WT + (size_t)(n_dst0 + n) * ldt + k0 + 8 * c) = o; }
    LDS_WAIT(); asm volatile("" ::: "memory");
}

#define RLX_AGENT __ATOMIC_RELAXED, __HIP_MEMORY_SCOPE_AGENT
#define XB_TMO      128
#define XB_XCNT(j)  (256  + 64 * (j))
#define XB_XSUB(j)  (1280 + 64 * (j))
#define XB_XGEN(j)  (2304 + 64 * (j))
#define XB_TOP      3328
#define XB_TOPGEN   3392
#define XCD_BAR_WORDS 3456
#define XB_SPIN_CAP (1u << 18)

__device__ __forceinline__ unsigned xb_ld(unsigned* p)              { return __hip_atomic_load(p, __ATOMIC_RELAXED, __HIP_MEMORY_SCOPE_AGENT); }
__device__ __forceinline__ unsigned xb_add(unsigned* p, unsigned v) { return __hip_atomic_fetch_add(p, v, __ATOMIC_RELAXED, __HIP_MEMORY_SCOPE_AGENT); }
__device__ __forceinline__ unsigned xb_xcc_id() { return (unsigned)__builtin_amdgcn_s_getreg((3 << 11) | 20) & 0xFu; }
#define XB_SPIN(cond, bar) do { unsigned _sp = 0; while (cond) { __builtin_amdgcn_s_sleep(1); \
    if ((++_sp & 255u) == 0u) { if (xb_ld(&(bar)[XB_TMO])) break; if (_sp > XB_SPIN_CAP) { atomicAdd(&(bar)[XB_TMO], 1u); break; } } } } while (0)

struct XcdBarrier {
    unsigned* bar; unsigned x;
    volatile LAS unsigned* st;
};

__device__ __forceinline__ XcdBarrier xcd_barrier_post(unsigned* bar, volatile LAS unsigned* st) {
    XcdBarrier b; b.bar = bar; b.x = xb_xcc_id(); b.st = st;
    if (threadIdx.x == 0) (void)xb_add(&bar[XB_XCNT(b.x)], 1u);
    return b;
}
__device__ __forceinline__ void xcd_barrier_complete(unsigned* bar, unsigned x, unsigned& nloc, unsigned& nx) {
    const unsigned G = gridDim.x * gridDim.y * gridDim.z;
    unsigned sum, cnt, mine, sp = 0u;
    for (;;) {
        sum = 0u; cnt = 0u; mine = 0u;
#pragma unroll
        for (unsigned j = 0; j < 16; ++j) { const unsigned c = xb_ld(&bar[XB_XCNT(j)]); sum += c; cnt += (c > 0u) ? 1u : 0u; mine = (j == x) ? c : mine; }
        if (sum == G) break;
        __builtin_amdgcn_s_sleep(1);
        if ((++sp & 255u) == 0u) { if (xb_ld(&bar[XB_TMO])) break; if (sp > XB_SPIN_CAP) { atomicAdd(&bar[XB_TMO], 1u); break; } }
    }
    nloc = mine > 0u ? mine : 1u; nx = cnt > 0u ? cnt : 1u;
}

__device__ __forceinline__ void xcd_barrier(const XcdBarrier& b) {
    asm volatile("s_waitcnt vmcnt(0)" ::: "memory");
    __syncthreads();
    if (threadIdx.x == 0) {
        unsigned* bar = b.bar;
        __builtin_amdgcn_s_waitcnt(0);
        unsigned nloc = b.st[0], nx = b.st[1];
        if (nloc == 0u) { xcd_barrier_complete(bar, b.x, nloc, nx); b.st[0] = nloc; b.st[1] = nx; }
        const unsigned old = xb_add(&bar[XB_XSUB(b.x)], 1u);
        const unsigned gen = old / nloc;
        if (old + 1u == (gen + 1u) * nloc) {
            __builtin_amdgcn_fence(__ATOMIC_RELEASE, "agent");
            asm volatile("s_waitcnt vmcnt(0)" ::: "memory");
            const unsigned og = xb_add(&bar[XB_TOP], 1u);
            const unsigned tg = og / nx;
            if (og + 1u == (tg + 1u) * nx) xb_add(&bar[XB_TOPGEN], 1u);
            else XB_SPIN(xb_ld(&bar[XB_TOPGEN]) == tg, bar);
            __builtin_amdgcn_fence(__ATOMIC_ACQUIRE, "agent");
            xb_add(&bar[XB_XGEN(b.x)], 1u);
            asm volatile("s_waitcnt vmcnt(0)" ::: "memory");
        } else {
            XB_SPIN(xb_ld(&bar[XB_XGEN(b.x)]) == gen, bar);
            __builtin_amdgcn_fence(__ATOMIC_ACQUIRE, "agent");
            asm volatile("s_waitcnt vmcnt(0)" ::: "memory");
        }
    }
    __syncthreads();
}

struct Args { const float* in[15]; float* out; unsigned char* ws; int ph_lo, ph_hi; };

__global__ void __launch_bounds__(NWAVES * 64, 2) fused_fwd(Args args) {
    extern __shared__ __attribute__((aligned(16))) unsigned char lds_raw[];
    LAS unsigned char* lds = (LAS unsigned char*)lds_raw;
    cg::grid_group grid = cg::this_grid();
    const int tid = threadIdx.x, lane = tid & 63, wave = __builtin_amdgcn_readfirstlane(tid >> 6);
    const int G = gridDim.x, bx = blockIdx.x;
    unsigned char* ws = args.ws;
    const float* x = args.in[0]; const float* attn_g = args.in[1]; const float* w_in = args.in[2]; const float* q_g = args.in[3]; const float* k_g = args.in[4]; const float* sgu_g = args.in[5];
    const float* w_sp = args.in[6]; const float* b_sp = args.in[7]; const float* sbo_g = args.in[8]; const float* sguo_g = args.in[9]; const float* w_out = args.in[10]; const float* ffn_g = args.in[11];
    const float* w_gate = args.in[12]; const float* w_up = args.in[13]; const float* w_down = args.in[14];
    bf16* Wtok = (bf16*)(ws + WS_WTOK); bf16* Wch = (bf16*)(ws + WS_WCH); bf16* Wout = (bf16*)(ws + WS_WOUT); bf16* Wgu = (bf16*)(ws + WS_WGU); bf16* Wdn = (bf16*)(ws + WS_WDN); bf16* Wsb = (bf16*)(ws + WS_WSB);
    float* rstd1 = (float*)(ws + WS_RSTD1); float* rstd2 = (float*)(ws + WS_RSTD2); float* rowsc = (float*)(ws + WS_ROWSC); float* gss = (float*)(ws + WS_GSS); float* ss2 = (float*)(ws + WS_SS2);
    bf16* XB = (bf16*)(ws + WS_XB); bf16* Qb = (bf16*)(ws + WS_Q); bf16* Kb = (bf16*)(ws + WS_K); bf16* Ub = (bf16*)(ws + WS_U); bf16* Vt = (bf16*)(ws + WS_VT); bf16* Gt = (bf16*)(ws + WS_GT);
    bf16* MIXED = (bf16*)(ws + WS_MIXED); bf16* X1B = (bf16*)(ws + WS_X1B); bf16* ACT = (bf16*)(ws + WS_ACT);
    const int lo = args.ph_lo, hi = args.ph_hi;
    for (int u = tid; u < (LDS_BYTES - RING_BYTES) / 4; u += NWAVES * 64) ((LAS unsigned*)(lds + RING_BYTES))[u] = 0u;
    __syncthreads();
    XcdBarrier bar; bar.bar = (unsigned*)ws; bar.x = 0; bar.st = nullptr;
    if (hi - lo > 1) bar = xcd_barrier_post((unsigned*)ws, (volatile LAS unsigned*)(lds + RING_BYTES + 352));
#define IN(k) (lo <= (k) && (k) < hi)
#define SEAM(k) do { if (IN(k) && IN((k) + 1)) { if (lo < 0) grid.sync();   else xcd_barrier(bar); } } while (0)

    if (IN(0)) {
        LAS float* scr = (LAS float*)(lds + wave * 16384);
        const int gw = bx * NWAVES + wave, NGW = G * NWAVES;
        constexpr int I1 = 48 * 16, I2 = 32 * 16, I3 = 32 * 16, I4 = 88 * 16, I5 = 88 * 16, I6 = 32 * 44, NITEMS = I1 + I2 + I3 + I4 + I5 + I6;
        for (int it = gw; it < NITEMS; it += NGW) {
            int r = it;
            if (r < I1) { const int kb = r / 48, nb = r % 48, region = nb / 16, cb = nb % 16; const int src = (region == 0 ? 0 : (region == 1 ? 512 : 1536)) + 32 * cb;
                const int dst = 512 * region + 256 * (cb / 8) + 128 * (cb & 1) + 32 * ((cb % 8) / 2);
                tr_item(w_in, 2560, 64 * kb, src, attn_g, Wtok, DM, dst, scr, lane); continue; } r -= I1;
            if (r < I2) { const int kb = r / 32, nb = r % 32; const int src = (nb < 16 ? 1024 : 2048) + 32 * (nb % 16);
                tr_item(w_in, 2560, 64 * kb, src, attn_g, Wch, DM, 32 * nb, scr, lane); continue; } r -= I2;
            if (r < I3) { const int kb = r / 32, nb = r % 32; tr_item(w_out, DM, 64 * kb, 32 * nb, nullptr, Wout, DM, 32 * nb, scr, lane); continue; } r -= I3;
            if (r < I4) { const int kb = r / 88, nb = r % 88; tr_item(w_gate, DFF, 64 * kb, 32 * nb, ffn_g, Wgu, DM, 256 * (nb / 4) + 32 * (nb % 4), scr, lane); continue; } r -= I4;
            if (r < I5) { const int kb = r / 88, nb = r % 88; tr_item(w_up, DFF, 64 * kb, 32 * nb, ffn_g, Wgu, DM, 256 * (nb / 4) + 128 + 32 * (nb % 4), scr, lane); continue; } r -= I5;
            { const int kb = r / 32, nb = r % 32; tr_item(w_down, DM, 64 * kb, 32 * nb, nullptr, Wdn, DFF, 32 * nb, scr, lane); }
        }
        for (int i = bx * (NWAVES * 64) + tid; i < 8 * 128 * 128; i += G * NWAVES * 64) { const int ii = (i >> 7) & 127, jj = i & 127; Wsb[(((((i >> 14) * 4 + (ii >> 5)) * 8 + (jj >> 4)) * 32 + (ii & 31)) * 2 + ((jj >> 3) & 1)) * 8 + (jj & 7)] = (bf16)(((jj >> 6) <= (ii >> 6)) ? f2bf(w_sp[i]) : 0u); }
        for (int m0 = 4 * gw; m0 < MTOK; m0 += 4 * NGW) {
            f32x4 v[4][4]; float s[4];
#pragma unroll
            for (int q = 0; q < 4; ++q) { const f32x4* xr = (const f32x4*)(x + (size_t)(m0 + q) * DM) + lane;
#pragma unroll
                for (int j = 0; j < 4; ++j) v[q][j] = xr[64 * j]; }
#pragma unroll
            for (int q = 0; q < 4; ++q) { float t = 0.f;
#pragma unroll
                for (int j = 0; j < 4; ++j) t += (v[q][j].x * v[q][j].x + v[q][j].y * v[q][j].y) + (v[q][j].z * v[q][j].z + v[q][j].w * v[q][j].w);
                s[q] = wave_sum(t); }
            if (lane < 4) rstd1[m0 + lane] = __builtin_amdgcn_rsqf((lane == 0 ? s[0] : lane == 1 ? s[1] : lane == 2 ? s[2] : s[3]) * (1.0f / DM) + pg8::NORM_EPS);
#pragma unroll
            for (int q = 0; q < 4; ++q) { unsigned long long* o8 = (unsigned long long*)(XB + (size_t)(m0 + q) * DM) + lane;
#pragma unroll
                for (int j = 0; j < 4; ++j) o8[64 * j] = (unsigned long long)pk2(v[q][j].x, v[q][j].y) | ((unsigned long long)pk2(v[q][j].z, v[q][j].w) << 32); }
        }
    }
    SEAM(0);

    if (IN(1)) {
        { pg8::Gemm g{XB, Wtok, MTOK, NTOK1, DM}; pg8::StaticOrder S; S.init(MTOK, NTOK1, G, bx);
          pg8::EpiTok1 E{Qb, (size_t)(WS_K - WS_Q) / 2, rstd1, q_g, k_g};
          pg8::gemm_phase<pg8::EpiTok1, pg8::StaticOrder, true, true>(lds, g, S, E); }
        { pg8::Gemm g{Wch, XB, NCH1, MTOK, DM}; pg8::StaticOrder S; S.init(NCH1, MTOK, G, bx);
          pg8::EpiCh1 E{Vt, Gt, rstd1, gss};
          pg8::gemm_phase<pg8::EpiCh1, pg8::StaticOrder, true, true>(lds, g, S, E); }
    }
    SEAM(1);

    if (IN(2)) {
        const mixp::MixArgs ma{Qb, Kb, Ub, Vt, Gt, Wsb, gss, b_sp, sgu_g, sbo_g, sguo_g, MIXED, rowsc};
        const int vcu = (G % 8 == 0) ? (bx % 8) * (G / 8) + bx / 8 : bx;
        const int mt = vcu; if (mt < MTOK / 256) {
            mixp::mix_phase(lds, ma, 2 * mt, 2 * mt + 2);
            asm volatile("s_waitcnt vmcnt(0)" ::: "memory"); __syncthreads();
            pg8::Gemm g{MIXED, Wout, MTOK, DM, DM}; pg8::OwnRows S{mt, DM / 256};
            pg8::EpiOut E{XB, X1B, ss2, (const LAS float*)(lds + pg8::STAGE_BYTES + 2048) + 256};
            pg8::gemm_phase<pg8::EpiOut, pg8::OwnRows, true, true, true>(lds, g, S, E, rowsc);
        }
    }
    SEAM(3);

    if (IN(4)) {
        pg8::Gemm g{X1B, Wgu, MTOK, NGU, DM}; pg8::StaticOrder S; S.init(MTOK, NGU, G, bx);
        pg8::gu_prepare_rstd(S, ss2, rstd2);
        pg8::EpiGU E{ACT, rstd2, DFF};
        pg8::gemm_phase<pg8::EpiGU, pg8::StaticOrder, true, true>(lds, g, S, E);
    }
    SEAM(4);

    if (IN(5)) {
        pg8::Gemm g{ACT, Wdn, MTOK, DM, DFF}; pg8::StaticOrder S; S.init(MTOK, DM, G, bx);
        pg8::EpiDown E{X1B, args.out};
        pg8::gemm_phase<pg8::EpiDown, pg8::StaticOrder, true, true>(lds, g, S, E);
    }
#undef IN
#undef SEAM
}

extern "C" void kernel_launch(void* const* d_in, const int* in_sizes, int n_in, void* d_out, int out_size, void* d_ws, size_t ws_size, hipStream_t stream) {
    static int grid = 0;
    if (grid == 0) {
        if (n_in != 15 || out_size != MTOK * DM || ws_size < WS_END) { fprintf(stderr, "kernel_launch: unexpected shapes (n_in %d, out %d, ws %zu)\n", n_in, out_size, ws_size); grid = -1; return; }
        int dev = 0, cus = 0, per_cu = 0;
        (void)hipGetDevice(&dev); (void)hipDeviceGetAttribute(&cus, hipDeviceAttributeMultiprocessorCount, dev);
        if (hipFuncSetAttribute((const void*)fused_fwd, hipFuncAttributeMaxDynamicSharedMemorySize, LDS_BYTES) != hipSuccess) { fprintf(stderr, "kernel_launch: hipFuncSetAttribute failed\n"); grid = -1; return; }
        if (hipOccupancyMaxActiveBlocksPerMultiprocessor(&per_cu, (const void*)fused_fwd, NWAVES * 64, LDS_BYTES) != hipSuccess || per_cu < 1) per_cu = 1;
        (void)hipGetLastError();
        grid = cus * per_cu;
        if (grid > MTOK / 256) grid = MTOK / 256;
        if (grid != MTOK / 256) fprintf(stderr, "kernel_launch: %d resident workgroups, this kernel needs %d (256 CUs x 1)\n", grid, MTOK / 256);
    }
    if (grid < 0) return;
    if (hipMemsetAsync(d_ws, 0, 16384, stream) != hipSuccess) { fprintf(stderr, "kernel_launch: memset of the barrier words failed\n"); return; }
    Args a{};
    for (int i = 0; i < 15; ++i) a.in[i] = (const float*)d_in[i];
    a.out = (float*)d_out; a.ws = (unsigned char*)d_ws;
#if MK_N_LAUNCHES == 1
    a.ph_lo = 0; a.ph_hi = 6;
    void* params[] = {&a};
    const hipError_t e = hipLaunchCooperativeKernel((const void*)fused_fwd, dim3(grid), dim3(NWAVES * 64), params, LDS_BYTES, stream);
    if (e != hipSuccess) fprintf(stderr, "kernel_launch: cooperative launch failed: %s (grid %d)\n", hipGetErrorString(e), grid);
#else
    for (int p = 0; p < 6; ++p) { a.ph_lo = p; a.ph_hi = p + 1; hipLaunchKernelGGL(fused_fwd, dim3(grid), dim3(NWAVES * 64), LDS_BYTES, stream, a); }
#endif
}
```

```cpp
#include <hip/hip_runtime.h>
#include <hip/hip_cooperative_groups.h>
#include <cstdio>
#include <cstdint>
namespace cg = cooperative_groups;
#define MK_N_LAUNCHES 1
namespace pg8 {
#define PG8_LAS __attribute__((address_space(3)))
typedef unsigned short bf16_t;
typedef short bf16x8 __attribute__((ext_vector_type(8)));
typedef float f32x4 __attribute__((ext_vector_type(4)));
typedef unsigned u32x4 __attribute__((ext_vector_type(4)));
constexpr int BM = 256, BK = 64, HALF = 128, HTB = HALF * BK * 2  , STAGE_BYTES = 8 * HTB, NXCD = 8, WGM = 8;

__host__ __device__ __forceinline__ int lds_byte(int r, int c) { const int st = (r >> 4) * 2 + (c >> 5), rr = r & 15, cc = c & 31, ob = rr * 64 + cc * 2; return st * 1024 + (ob ^ (((ob >> 9) & 1) << 5)); }
__host__ __device__ __forceinline__ void stage_rc(int b, int& R, int& C) { const int st = b / 1024, sb = b % 1024, swz = sb ^ (((sb >> 9) & 1) << 5); R = (st >> 1) * 16 + swz / 64; C = (st & 1) * 32 + (swz % 64) / 2; }
__host__ __device__ __forceinline__ int perm32(int rho) { const int n = rho >> 4, i = rho & 15; return 8 * (i >> 2) + 4 * n + (i & 3); }

struct Unit { int pm, pn; };
struct Gemm { const bf16_t* A; const bf16_t* Bt; int M, N, K; };

struct StaticOrder {
    int nM, nN, nwg, G, c;
    __host__ __device__ void init(int M, int N, int G_, int c_) { nM = M / BM; nN = N / BM; nwg = nM * nN; G = G_; c = c_; }
    __host__ __device__ bool next(int i, Unit& u) const {
        const long L = (long)i * G + c; if (L >= nwg) return false;
        int wgid = (int)L; { const int q = nwg / NXCD, r = nwg % NXCD, xcd = wgid % NXCD, off = wgid / NXCD; wgid = (xcd < r ? xcd * (q + 1) : r * (q + 1) + (xcd - r) * q) + off; }
        const int nig = WGM * nN, gid = wgid / nig, fm = gid * WGM, gsz = (nM - fm) < WGM ? (nM - fm) : WGM;
        u.pm = fm + ((wgid % nig) % gsz); u.pn = (wgid % nig) / gsz; return true;
    }
    __device__ __forceinline__ void a_ready(const Unit&) const {}
    __device__ __forceinline__ void done(const Unit&) const {}
};

__device__ __forceinline__ unsigned cvt_pk_bf16(float lo, float hi) { unsigned r; asm volatile("v_cvt_pk_bf16_f32 %0, %1, %2" : "=v"(r) : "v"(lo), "v"(hi)); return r; }
typedef float f32x2 __attribute__((ext_vector_type(2)));
constexpr int MTOK = 65536;
constexpr int VPITCH = MTOK + 2112;
constexpr float NORM_EPS = 1e-6f;
constexpr float QSCALE = 0.125f * 1.4426950408889634f;
__device__ __forceinline__ f32x4 exp2_4(const f32x4 t) { return (f32x4){__builtin_amdgcn_exp2f(t[0]), __builtin_amdgcn_exp2f(t[1]), __builtin_amdgcn_exp2f(t[2]), __builtin_amdgcn_exp2f(t[3])}; }
__device__ __forceinline__ f32x4 rcp_4(const f32x4 t) { return (f32x4){__builtin_amdgcn_rcpf(t[0]), __builtin_amdgcn_rcpf(t[1]), __builtin_amdgcn_rcpf(t[2]), __builtin_amdgcn_rcpf(t[3])}; }
__device__ __forceinline__ f32x4 gelu_tanh4(const f32x4 x) {
    const f32x4 x2 = x * x, p = x2 * (-0.10294324f) + (-2.3022082f), t = x * p;
    return x * rcp_4(exp2_4(t) + 1.0f);
}
typedef unsigned u32x2 __attribute__((ext_vector_type(2)));
__device__ __forceinline__ u32x4 pack8(const f32x4 a, const f32x4 b) { u32x4 w; w.x = cvt_pk_bf16(a[0], a[1]); w.y = cvt_pk_bf16(a[2], a[3]); w.z = cvt_pk_bf16(b[0], b[1]); w.w = cvt_pk_bf16(b[2], b[3]); return w; }
__device__ __forceinline__ float sumsq4(const f32x4 a) { return (a[0] * a[0] + a[1] * a[1]) + (a[2] * a[2] + a[3] * a[3]); }

struct EpiTok1 {
    static constexpr bool PERM = true, AFTER_DRAIN = false;
    bf16_t* Q; size_t kind_stride; const float* rstd1; const float* qg; const float* kg;
    __device__ __forceinline__ void operator()(const f32x4 (&acc)[2][2][4][2], const Unit& u, int wr, int wc, int fr, int fq) const {
        const int kind = u.pn >> 1;
        bf16_t* base = Q + (size_t)kind * kind_stride;
        const int colb = (u.pn & 1) * 256 + wc * 64 + 8 * fq;
        const int row0 = u.pm * BM + wr * 64 + fr;
        f32x4 gv[2][2];
        if (kind < 2) { const float* gp = kind == 0 ? qg : kg; const float sc = kind == 0 ? QSCALE : 1.0f;
#pragma unroll
            for (int bj = 0; bj < 2; ++bj)
#pragma unroll
                for (int n = 0; n < 2; ++n) gv[bj][n] = *(const f32x4*)(gp + 32 * bj + 8 * fq + 4 * n) * sc;
        }
        float r1v[2][4];
#pragma unroll
        for (int ai = 0; ai < 2; ++ai)
#pragma unroll
            for (int m = 0; m < 4; ++m) r1v[ai][m] = rstd1[row0 + ai * HALF + m * 16];
#pragma unroll
        for (int ai = 0; ai < 2; ++ai)
#pragma unroll
            for (int m = 0; m < 4; ++m) {
                const int row = row0 + ai * HALF + m * 16;
                const float r1 = r1v[ai][m];
                f32x4 v[2][2];
#pragma unroll
                for (int bj = 0; bj < 2; ++bj)
#pragma unroll
                    for (int n = 0; n < 2; ++n) v[bj][n] = acc[ai][bj][m][n] * r1;
                if (kind < 2) {
                    float ss = (sumsq4(v[0][0]) + sumsq4(v[0][1])) + (sumsq4(v[1][0]) + sumsq4(v[1][1]));
                    ss += __shfl_xor(ss, 16); ss += __shfl_xor(ss, 32);
                    const float rn = __builtin_amdgcn_rsqf(ss * (1.0f / 64.0f) + NORM_EPS);
#pragma unroll
                    for (int bj = 0; bj < 2; ++bj)
#pragma unroll
                        for (int n = 0; n < 2; ++n) v[bj][n] = v[bj][n] * rn * gv[bj][n];
                } else {
#pragma unroll
                    for (int bj = 0; bj < 2; ++bj)
#pragma unroll
                        for (int n = 0; n < 2; ++n) v[bj][n] = gelu_tanh4(v[bj][n]);
                }
                const int hg = (u.pn & 1) * 4 + wc;
                if (kind < 2) {
                    bf16_t* kp = base + ((size_t)((row >> 5) * 8 + hg) * 4 * 64 + (row & 31) * 2 + (fq & 1)) * 8;
#pragma unroll
                    for (int bj = 0; bj < 2; ++bj) *(u32x4*)(kp + (size_t)(2 * bj + (fq >> 1)) * 512) = pack8(v[bj][0], v[bj][1]);
                } else {
#pragma unroll
                    for (int bj = 0; bj < 2; ++bj) { bf16_t* up = base + ((((size_t)((row >> 5) * 8 + hg) * 4 + 2 * bj + (fq >> 1)) * 64 + (row & 31) * 2) * 2 + (fq & 1)) * 4;
                        u32x2 w0, w1; w0.x = cvt_pk_bf16(v[bj][0][0], v[bj][0][1]); w0.y = cvt_pk_bf16(v[bj][0][2], v[bj][0][3]); w1.x = cvt_pk_bf16(v[bj][1][0], v[bj][1][1]); w1.y = cvt_pk_bf16(v[bj][1][2], v[bj][1][3]);
                        *(u32x2*)up = w0; *(u32x2*)(up + 8) = w1; }
                }
            }
    }
};

struct EpiCh1 {
    static constexpr bool PERM = true, AFTER_DRAIN = false;
    bf16_t* Vt; bf16_t* Gt; const float* rstd1; float* gss;
    __device__ __forceinline__ void operator()(const f32x4 (&acc)[2][2][4][2], const Unit& u, int wr, int wc, int fr, int fq) const {
        const int tok0 = u.pn * BM + wc * 32 + 8 * fq;
        f32x4 rs[2][2];
#pragma unroll
        for (int bj = 0; bj < 2; ++bj)
#pragma unroll
            for (int n = 0; n < 2; ++n) rs[bj][n] = *(const f32x4*)(rstd1 + tok0 + bj * HALF + 4 * n);
        const bool isg = u.pm >= 2;
        const int ch0 = (u.pm & 1) * 256 + wr * 64 + fr;
        f32x4 sq[2][2];
#pragma unroll
        for (int bj = 0; bj < 2; ++bj)
#pragma unroll
            for (int n = 0; n < 2; ++n) sq[bj][n] = (f32x4){0.f, 0.f, 0.f, 0.f};
#pragma unroll
        for (int ai = 0; ai < 2; ++ai)
#pragma unroll
            for (int m = 0; m < 4; ++m) {
#pragma unroll
                for (int bj = 0; bj < 2; ++bj) {
                    f32x4 v0 = acc[ai][bj][m][0] * rs[bj][0], v1 = acc[ai][bj][m][1] * rs[bj][1];
                    if (isg) {
                        v0 = gelu_tanh4(v0); v1 = gelu_tanh4(v1);
                        sq[bj][0] += v0 * v0; sq[bj][1] += v1 * v1;
                    }
                    if (isg) { const int ch = ch0 + ai * HALF + m * 16;
                        *(u32x4*)(Gt + (((((size_t)(u.pn * 2 + bj) * 8 + (ch >> 6)) * 2 + ((ch >> 5) & 1)) * 8 + 2 * wc + (fq >> 1)) * 64 + (ch & 31) * 2 + (fq & 1)) * 8) = pack8(v0, v1); }
                    else {
                        const int ch = ch0 + ai * HALF + m * 16, tb = u.pn * 8 + bj * 4 + wc;
                        bf16_t* vp = Vt + ((size_t)(((tb * 8 + (ch >> 6)) * 2 + ((ch >> 5) & 1)) * 2 + (fq >> 1)) * 64 + (ch & 31) * 2) * 8 + (fq & 1) * 4;
                        u32x2 w0, w1; w0.x = cvt_pk_bf16(v0[0], v0[1]); w0.y = cvt_pk_bf16(v0[2], v0[3]); w1.x = cvt_pk_bf16(v1[0], v1[1]); w1.y = cvt_pk_bf16(v1[2], v1[3]);
                        *(u32x2*)vp = w0; *(u32x2*)(vp + 8) = w1; }
                }
            }
        if (isg) {
#pragma unroll
            for (int bj = 0; bj < 2; ++bj)
#pragma unroll
                for (int n = 0; n < 2; ++n)
#pragma unroll
                    for (int e = 0; e < 4; ++e) { float s = sq[bj][n][e]; s += __shfl_xor(s, 1); s += __shfl_xor(s, 2); s += __shfl_xor(s, 4); s += __shfl_xor(s, 8); sq[bj][n][e] = s; }
            if (fr == 0) { float* gp = gss + (size_t)((u.pm - 2) * 2 + wr) * MTOK + tok0;
#pragma unroll
                for (int bj = 0; bj < 2; ++bj)
#pragma unroll
                    for (int n = 0; n < 2; ++n) *(f32x4*)(gp + bj * HALF + 4 * n) = sq[bj][n]; }
        }
    }
};

struct EpiOut {
    static constexpr bool PERM = true, AFTER_DRAIN = false;
    const bf16_t* xb; bf16_t* x1b; float* ss2; const PG8_LAS float* rbl;
    __device__ __forceinline__ void operator()(const f32x4 (&acc)[2][2][4][2], const Unit& u, int wr, int wc, int fr, int fq) const {
        const int col0 = u.pn * BM + wc * 32 + 8 * fq;
        const int row0 = u.pm * BM + wr * 64 + fr;
#pragma unroll
        for (int ai = 0; ai < 2; ++ai) {
            u32x4 xr[4][2]; float rbv[4];
#pragma unroll
            for (int m = 0; m < 4; ++m) { rbv[m] = rbl[wr * 64 + fr + ai * HALF + m * 16];
#pragma unroll
                for (int bj = 0; bj < 2; ++bj) xr[m][bj] = *(const u32x4*)(xb + (size_t)(row0 + ai * HALF + m * 16) * 1024 + col0 + bj * HALF); }
#pragma unroll
            for (int m = 0; m < 4; ++m) {
                const int row = row0 + ai * HALF + m * 16; const size_t off = (size_t)row * 1024 + col0;
                float ss = 0.f;
#pragma unroll
                for (int bj = 0; bj < 2; ++bj) { const u32x4 r = xr[m][bj];
                    const f32x4 x0 = {__uint_as_float(r.x << 16), __uint_as_float(r.x & 0xffff0000u), __uint_as_float(r.y << 16), __uint_as_float(r.y & 0xffff0000u)};
                    const f32x4 x1 = {__uint_as_float(r.z << 16), __uint_as_float(r.z & 0xffff0000u), __uint_as_float(r.w << 16), __uint_as_float(r.w & 0xffff0000u)};
                    const f32x4 v0 = acc[ai][bj][m][0] * rbv[m] + x0, v1 = acc[ai][bj][m][1] * rbv[m] + x1;
                    *(u32x4*)(x1b + off + bj * HALF) = pack8(v0, v1);
                    ss += sumsq4(v0) + sumsq4(v1);
                }
                ss += __shfl_xor(ss, 16); ss += __shfl_xor(ss, 32);
                if (fq == 0) ss2[(size_t)row * 16 + u.pn * 4 + wc] = ss;
            }
        }
    }
};

struct EpiGU {
    static constexpr bool PERM = true, AFTER_DRAIN = false;
    bf16_t* act; const float* rstd2; int ldc;
    __device__ __forceinline__ void operator()(const f32x4 (&acc)[2][2][4][2], const Unit& u, int wr, int wc, int fr, int fq) const {
        const int col0 = u.pn * HALF + wc * 32 + 8 * fq;
        const int row0 = u.pm * BM + wr * 64 + fr;
        float rv[2][4];
#pragma unroll
        for (int ai = 0; ai < 2; ++ai)
#pragma unroll
            for (int m = 0; m < 4; ++m) rv[ai][m] = rstd2[row0 + ai * HALF + m * 16];
#pragma unroll
        for (int ai = 0; ai < 2; ++ai)
#pragma unroll
            for (int m = 0; m < 4; ++m) {
                const int row = row0 + ai * HALF + m * 16;
                const float r = rv[ai][m], c1 = -1.4426950408889634f * r, r2 = r * r;
                f32x4 o[2];
#pragma unroll
                for (int n = 0; n < 2; ++n) { const f32x4 g = acc[ai][0][m][n], uu = acc[ai][1][m][n];
                    o[n] = (g * uu) * (rcp_4(exp2_4(g * c1) + 1.0f) * r2); }
                *(u32x4*)(act + (size_t)row * ldc + col0) = pack8(o[0], o[1]);
            }
    }
};
template <class Sched> __device__ __forceinline__ void gu_prepare_rstd(const Sched& S, const float* ss2, float* rstd2) {
    const int tid = threadIdx.x; Unit u; int last = -1;
    for (int i = 0; S.next(i, u); ++i) if (u.pm != last) { last = u.pm;
        const int row = u.pm * BM + (tid >> 1); const f32x4* sp = (const f32x4*)(ss2 + (size_t)row * 16) + (tid & 1) * 2;
        const f32x4 p = sp[0] + sp[1]; float s = (p[0] + p[1]) + (p[2] + p[3]); s += __shfl_xor(s, 1);
        if (!(tid & 1)) rstd2[row] = __builtin_amdgcn_rsqf(s * (1.0f / 1024.0f) + NORM_EPS); }
    asm volatile("s_waitcnt vmcnt(0)" ::: "memory"); __syncthreads();
}

struct EpiDown {
    static constexpr bool PERM = true, AFTER_DRAIN = false;
    const bf16_t* x1b; float* out;
    __device__ __forceinline__ void operator()(const f32x4 (&acc)[2][2][4][2], const Unit& u, int wr, int wc, int fr, int fq) const {
        const int col0 = u.pn * BM + wc * 32 + 8 * fq;
        const int row0 = u.pm * BM + wr * 64 + fr;
        u32x4 rr[2][4][2];
#pragma unroll
        for (int ai = 0; ai < 2; ++ai)
#pragma unroll
            for (int m = 0; m < 4; ++m)
#pragma unroll
                for (int bj = 0; bj < 2; ++bj) rr[ai][m][bj] = *(const u32x4*)(x1b + (size_t)(row0 + ai * HALF + m * 16) * 1024 + col0 + bj * HALF);
#pragma unroll
        for (int ai = 0; ai < 2; ++ai)
#pragma unroll
            for (int m = 0; m < 4; ++m) {
                const size_t off = (size_t)(row0 + ai * HALF + m * 16) * 1024 + col0;
#pragma unroll
                for (int bj = 0; bj < 2; ++bj) { const u32x4 r = rr[ai][m][bj];
                    const f32x4 r0 = {__uint_as_float(r.x << 16), __uint_as_float(r.x & 0xffff0000u), __uint_as_float(r.y << 16), __uint_as_float(r.y & 0xffff0000u)};
                    const f32x4 r1 = {__uint_as_float(r.z << 16), __uint_as_float(r.z & 0xffff0000u), __uint_as_float(r.w << 16), __uint_as_float(r.w & 0xffff0000u)};
                    *(f32x4*)(out + off + bj * HALF) = r0 + acc[ai][bj][m][0]; *(f32x4*)(out + off + bj * HALF + 4) = r1 + acc[ai][bj][m][1]; }
            }
    }
};
template <class Epi, class Sched, bool ALIGN_EPI = false, bool SP2 = false, bool MID = false>
__device__ __forceinline__ void gemm_phase(PG8_LAS unsigned char* lds, const Gemm g, const Sched& S, const Epi& E, const float* mid_scale = nullptr) {
    const int tid = threadIdx.x, wid = __builtin_amdgcn_readfirstlane(tid >> 6), lane = tid & 63, wr = wid >> 2, wc = wid & 3, fr = lane & 15, fq = lane >> 4;
    const int K = g.K, nt = K / BK;
    unsigned voffA[2], voffB[2];
#pragma unroll
    for (int i = 0; i < 2; ++i) { int R, C; stage_rc(tid * 16 + i * 8192, R, C); const int Rb = Epi::PERM ? ((R & ~31) + perm32(R & 31)) : R;
        voffA[i] = (unsigned)(R * K + C) * 2u; voffB[i] = (unsigned)(Rb * K + C) * 2u; }
    const size_t kstep = (size_t)(BK * 2);
    const size_t hstep = (size_t)HALF * K * 2;
    const size_t tstep = 2 * hstep;
    const unsigned ldsw = (unsigned)wid * 1024u;
    const int aoff = lds_byte(wr * 64 + fr, fq * 8), boff = lds_byte(wc * 32 + fr, fq * 8);
#define PG8_SA(b, h) (((b) * 2 + (h)) * HTB)
#define PG8_SB(b, h) ((4 + (b) * 2 + (h)) * HTB)
#define PG8_STAGE(bufoff, gbase, voff) do { _Pragma("unroll") for (int _i = 0; _i < 2; ++_i) \
        __builtin_amdgcn_global_load_lds((const unsigned*)((const char*)(gbase) + (voff)[_i]), (PG8_LAS unsigned*)(lds + (bufoff) + ldsw + _i * 8192), 16, 0, 0); } while (0)
#define PG8_LDA(dst, b, h) do { _Pragma("unroll") for (int m = 0; m < 4; ++m) _Pragma("unroll") for (int k = 0; k < 2; ++k) dst[m][k] = *(const PG8_LAS bf16x8*)(lds + PG8_SA(b, h) + aoff + m * 2048 + k * 1024); } while (0)
#define PG8_LDB(dst, b, h) do { _Pragma("unroll") for (int n = 0; n < 2; ++n) _Pragma("unroll") for (int k = 0; k < 2; ++k) dst[n][k] = *(const PG8_LAS bf16x8*)(lds + PG8_SB(b, h) + boff + n * 2048 + k * 1024); } while (0)
#define PG8_MMA(ai, bj, At, Bt) do { __builtin_amdgcn_s_setprio(1); _Pragma("unroll") for (int m = 0; m < 4; ++m) _Pragma("unroll") for (int n = 0; n < 2; ++n) _Pragma("unroll") for (int k = 0; k < 2; ++k) \
        acc[ai][bj][m][n] = __builtin_amdgcn_mfma_f32_16x16x32_bf16(Bt[n][k], At[m][k], acc[ai][bj][m][n], 0, 0, 0); __builtin_amdgcn_s_setprio(0); } while (0)
#define PG8_WAIT_V(n) asm volatile("s_waitcnt vmcnt(" #n ")" ::: "memory")
#define PG8_WAIT_L(n) asm volatile("s_waitcnt lgkmcnt(" #n ")" ::: "memory")
#define PG8_BAR __builtin_amdgcn_s_barrier()
#define PG8_SCHED __builtin_amdgcn_sched_barrier(0)
    Unit cur, nxt; int ui = 0;
    if (!S.next(0, cur)) return;
    f32x4 acc[2][2][4][2];
#pragma unroll
    for (int a = 0; a < 2; ++a)
#pragma unroll
        for (int b = 0; b < 2; ++b)
#pragma unroll
            for (int m = 0; m < 4; ++m)
#pragma unroll
                for (int n = 0; n < 2; ++n) acc[a][b][m][n] = (f32x4){0.f, 0.f, 0.f, 0.f};
    bf16x8 At[4][2], B0[2][2], B1[2][2];
    const char* cA = (const char*)g.A + (size_t)cur.pm * tstep; const char* cB = (const char*)g.Bt + (size_t)cur.pn * tstep;
    S.a_ready(cur);
    if constexpr (SP2) {
        PG8_STAGE(PG8_SB(0, 0), cB, voffB); PG8_STAGE(PG8_SB(0, 1), cB + hstep, voffB); PG8_STAGE(PG8_SA(0, 0), cA, voffA); PG8_STAGE(PG8_SA(0, 1), cA + hstep, voffA);
        if (wr == 1) PG8_BAR;
        PG8_WAIT_V(2); PG8_BAR;
        PG8_STAGE(PG8_SB(1, 0), cB + kstep, voffB); PG8_STAGE(PG8_SA(1, 0), cA + kstep, voffA); PG8_STAGE(PG8_SB(1, 1), cB + hstep + kstep, voffB);
        PG8_WAIT_V(6); PG8_BAR;
    } else {
        PG8_STAGE(PG8_SB(0, 0), cB, voffB); PG8_STAGE(PG8_SA(0, 0), cA, voffA); PG8_STAGE(PG8_SB(0, 1), cB + hstep, voffB); PG8_STAGE(PG8_SA(0, 1), cA + hstep, voffA);
        if (wr == 1) PG8_BAR;
        PG8_WAIT_V(4); PG8_BAR;
        PG8_STAGE(PG8_SB(1, 0), cB + kstep, voffB); PG8_STAGE(PG8_SA(1, 0), cA + kstep, voffA); PG8_STAGE(PG8_SB(1, 1), cB + hstep + kstep, voffB);
        PG8_WAIT_V(6); PG8_BAR;
    }
    for (;;) {
        const bool has_next = S.next(ui + 1, nxt);
        const char* nA = has_next ? (const char*)g.A + (size_t)nxt.pm * tstep : cA; const char* nB = has_next ? (const char*)g.Bt + (size_t)nxt.pn * tstep : cB;
        for (int t = 0; t < nt; t += 2) {
            const bool last = (t == nt - 2);
            if constexpr (MID) {
                PG8_LAS float* midl = (PG8_LAS float*)(lds + STAGE_BYTES + 2048);
                if (t == (nt >> 1) - 2) { if (tid < 256) { const f32x2 ms = *(const f32x2*)(mid_scale + 2 * (cur.pm * BM + tid)); midl[tid] = ms.x; midl[256 + tid] = ms.y; } }
                if (t == (nt >> 1)) { const PG8_LAS float* mp_ = midl + wr * 64 + fr;
#pragma unroll
                    for (int a_ = 0; a_ < 2; ++a_)
#pragma unroll
                        for (int m_ = 0; m_ < 4; ++m_) { const float rr = mp_[a_ * HALF + m_ * 16];
#pragma unroll
                            for (int b_ = 0; b_ < 2; ++b_)
#pragma unroll
                                for (int n_ = 0; n_ < 2; ++n_) acc[a_][b_][m_][n_] = acc[a_][b_][m_][n_] * rr; } } }
            const char* a1 = cA + (size_t)(t + 1) * kstep;
            const char* a2 = last ? nA : cA + (size_t)(t + 2) * kstep; const char* b2 = last ? nB : cB + (size_t)(t + 2) * kstep;
            const char* a3 = a2 + kstep; const char* b3 = b2 + kstep;
            if (last && has_next) S.a_ready(nxt);
            if constexpr (SP2) {
            PG8_LDB(B0, 0, 0); PG8_LDB(B1, 0, 1); PG8_SCHED; PG8_LDA(At, 0, 0); PG8_STAGE(PG8_SA(1, 1), a1 + hstep, voffA);
            PG8_WAIT_V(8); PG8_WAIT_L(0); PG8_BAR; PG8_MMA(0, 0, At, B0); PG8_MMA(0, 1, At, B1); PG8_BAR; PG8_SCHED;
            PG8_LDA(At, 0, 1); PG8_STAGE(PG8_SB(0, 0), b2, voffB); PG8_STAGE(PG8_SB(0, 1), b2 + hstep, voffB); PG8_STAGE(PG8_SA(0, 0), a2, voffA);
            PG8_WAIT_V(8); PG8_WAIT_L(0); PG8_BAR; PG8_MMA(1, 0, At, B0); PG8_MMA(1, 1, At, B1); PG8_BAR; PG8_SCHED;
            PG8_LDB(B0, 1, 0); PG8_LDB(B1, 1, 1); PG8_SCHED; PG8_LDA(At, 1, 0); PG8_STAGE(PG8_SA(0, 1), a2 + hstep, voffA);
            PG8_WAIT_V(8); PG8_WAIT_L(0); PG8_BAR; PG8_MMA(0, 0, At, B0); PG8_MMA(0, 1, At, B1); PG8_BAR; PG8_SCHED;
            PG8_LDA(At, 1, 1); PG8_STAGE(PG8_SB(1, 0), b3, voffB); PG8_STAGE(PG8_SB(1, 1), b3 + hstep, voffB); PG8_STAGE(PG8_SA(1, 0), a3, voffA);
            PG8_WAIT_V(8); PG8_WAIT_L(0); PG8_BAR; PG8_MMA(1, 0, At, B0); PG8_MMA(1, 1, At, B1); PG8_BAR; PG8_SCHED;
            } else {
            PG8_LDB(B0, 0, 0); PG8_SCHED; PG8_LDA(At, 0, 0); PG8_STAGE(PG8_SA(1, 1), a1 + hstep, voffA);
            PG8_WAIT_L(8); PG8_BAR; PG8_WAIT_L(0); PG8_MMA(0, 0, At, B0); PG8_BAR; PG8_SCHED;
            PG8_LDB(B1, 0, 1); PG8_STAGE(PG8_SB(0, 0), b2, voffB);
            PG8_BAR; PG8_WAIT_L(0); PG8_MMA(0, 1, At, B1); PG8_BAR;
            PG8_LDA(At, 0, 1); PG8_STAGE(PG8_SA(0, 0), a2, voffA);
            PG8_BAR; PG8_WAIT_L(0); PG8_MMA(1, 0, At, B0); PG8_BAR; PG8_SCHED;
            PG8_STAGE(PG8_SB(0, 1), b2 + hstep, voffB);
            PG8_WAIT_V(6); PG8_BAR; PG8_MMA(1, 1, At, B1); PG8_BAR;
            PG8_LDB(B0, 1, 0); PG8_SCHED; PG8_LDA(At, 1, 0); PG8_STAGE(PG8_SA(0, 1), a2 + hstep, voffA);
            PG8_WAIT_L(8); PG8_BAR; PG8_WAIT_L(0); PG8_MMA(0, 0, At, B0); PG8_BAR; PG8_SCHED;
            PG8_LDB(B1, 1, 1); PG8_STAGE(PG8_SB(1, 0), b3, voffB);
            PG8_BAR; PG8_WAIT_L(0); PG8_MMA(0, 1, At, B1); PG8_BAR;
            PG8_LDA(At, 1, 1); PG8_STAGE(PG8_SA(1, 0), a3, voffA);
            PG8_BAR; PG8_WAIT_L(0); PG8_MMA(1, 0, At, B0); PG8_BAR; PG8_SCHED;
            PG8_STAGE(PG8_SB(1, 1), b3 + hstep, voffB);
            PG8_WAIT_V(6); PG8_BAR; PG8_MMA(1, 1, At, B1); PG8_BAR;
            }
        }
        if constexpr (ALIGN_EPI) { if (wr == 0) PG8_BAR; }
        if constexpr (!Epi::AFTER_DRAIN) { E(acc, cur, wr, wc, fr, fq); S.done(cur); }
        if (!has_next) break;
#pragma unroll
        for (int a = 0; a < 2; ++a)
#pragma unroll
            for (int b = 0; b < 2; ++b)
#pragma unroll
                for (int m = 0; m < 4; ++m)
#pragma unroll
                    for (int n = 0; n < 2; ++n) acc[a][b][m][n] = (f32x4){0.f, 0.f, 0.f, 0.f};
        cur = nxt; cA = nA; cB = nB; ++ui;
        if constexpr (ALIGN_EPI) { if (wr == 1) PG8_BAR; }
    }
    PG8_WAIT_V(0);
    if constexpr (!ALIGN_EPI) { if (wr == 0) PG8_BAR; }
    PG8_BAR;
    if constexpr (Epi::AFTER_DRAIN) { E.fused(acc, cur, wr, wc, fr, fq, lds, wid, lane); S.done(cur); }
#undef PG8_SA
#undef PG8_SB
#undef PG8_STAGE
#undef PG8_LDA
#undef PG8_LDB
#undef PG8_MMA
#undef PG8_WAIT_V
#undef PG8_WAIT_L
#undef PG8_BAR
#undef PG8_SCHED
}
}

namespace mixp {
using pg8::bf16_t; using pg8::bf16x8; using pg8::f32x4; using pg8::u32x4; using pg8::MTOK; using pg8::VPITCH; using pg8::NORM_EPS;
typedef float f32x16 __attribute__((ext_vector_type(16)));
typedef short s16x4 __attribute__((ext_vector_type(4)));
typedef unsigned u32x2 __attribute__((ext_vector_type(2)));
typedef float f32x2_t __attribute__((ext_vector_type(2))); typedef __bf16 bf16x2_t __attribute__((ext_vector_type(2)));
#define MX_LAS __attribute__((address_space(3)))
#define MFMA32(a, b, c) __builtin_amdgcn_mfma_f32_32x32x16_bf16((a), (b), (c), 0, 0, 0)
__device__ __forceinline__ unsigned cvtpk(float lo, float hi) { f32x2_t v = {lo, hi}; bf16x2_t b = __builtin_convertvector(v, bf16x2_t); return __builtin_bit_cast(unsigned, b); }
__device__ __forceinline__ float bf2f(short s) { return __uint_as_float(((unsigned)(unsigned short)s) << 16); }
__device__ __forceinline__ float half_sum(float v) { auto rr = __builtin_amdgcn_permlane32_swap(__float_as_uint(v), __float_as_uint(v), false, false); return __uint_as_float(rr[0]) + __uint_as_float(rr[1]); }

struct MixArgs { const bf16_t *Q, *K, *U, *Vt, *Gt, *Wsb; const float *gss, *bsp, *sgn, *gA, *gB; bf16_t* mixed; float* rowsc; };

__device__ __forceinline__ void mix_phase(MX_LAS unsigned char* lds, const MixArgs& a, int G, int bid) {
    const int tid = threadIdx.x, lane = tid & 63, l32 = lane & 31, hi = lane >> 5;
    const int w = __builtin_amdgcn_readfirstlane(tid >> 6);
    MX_LAS bf16x8* gnl = (MX_LAS bf16x8*)(lds + w * 16384) + lane;
    MX_LAS float* rgs = (MX_LAS float*)(lds + 131072 + 512);
    MX_LAS float* rtab = (MX_LAS float*)(lds + 131072 + 1024);
    MX_LAS float* part = (MX_LAS float*)(lds + 131072 + 2048);
    MX_LAS float* gtab = (MX_LAS float*)(lds + 131072 + 10240);
    const f32x16 zero16 = {0.f, 0.f, 0.f, 0.f, 0.f, 0.f, 0.f, 0.f, 0.f, 0.f, 0.f, 0.f, 0.f, 0.f, 0.f, 0.f};
    { gtab[tid] = a.gA[tid]; gtab[512 + tid] = a.gB[tid]; }
    const MX_LAS float* gl = gtab + 64 * w + 4 * hi;
    const int vcu = (G % 8 == 0) ? (bid % 8) * (G / 8) + bid / 8 : bid;
    for (int unit = vcu; unit < MTOK / 128; unit += G) {
        const int tok0 = unit * 128;
        const int s0 = (unit & 63) * 128;
        const size_t seq0 = (size_t)(unit >> 6) * 8192;
        if (tid < 128) { const int t = tok0 + tid; const float s = (a.gss[t] + a.gss[MTOK + t]) + (a.gss[2 * MTOK + t] + a.gss[3 * MTOK + t]); rgs[tid] = __builtin_amdgcn_rsqf(s * (1.0f / 512.0f) + NORM_EPS); }
        __syncthreads();
#pragma unroll
        for (int cb = 0; cb < 2; ++cb) { const int c = 64 * w + 32 * cb + l32; const float sg = a.sgn[c]; const bf16_t* gp = a.Gt + (((size_t)unit * 8 + w) * 2 + cb) * 8 * 512 + (l32 * 2 + hi) * 8;
            bf16x8 raw[8];
#pragma unroll
            for (int kk = 0; kk < 8; ++kk) raw[kk] = *(const bf16x8*)(gp + kk * 512);
#pragma unroll
            for (int kk = 0; kk < 8; ++kk) {
                const f32x4 r0 = *(const MX_LAS f32x4*)(rgs + 16 * kk + 8 * hi) * sg, r1 = *(const MX_LAS f32x4*)(rgs + 16 * kk + 8 * hi + 4) * sg;
                u32x4 pk; pk.x = cvtpk(bf2f(raw[kk][0]) * r0[0], bf2f(raw[kk][1]) * r0[1]); pk.y = cvtpk(bf2f(raw[kk][2]) * r0[2], bf2f(raw[kk][3]) * r0[3]);
                pk.z = cvtpk(bf2f(raw[kk][4]) * r1[0], bf2f(raw[kk][5]) * r1[1]); pk.w = cvtpk(bf2f(raw[kk][6]) * r1[2], bf2f(raw[kk][7]) * r1[3]);
                gnl[(cb * 8 + kk) * 64] = __builtin_bit_cast(bf16x8, pk); } }
#define MX_STORE2(X, GP, COFF) do { _Pragma("unroll") for (int k = 0; k < 4; k += 2) { \
                const f32x4 g0 = *(const MX_LAS f32x4*)((GP) + 8 * k), g1 = *(const MX_LAS f32x4*)((GP) + 8 * k + 8); \
                unsigned ax = cvtpk(X[4 * k] * g0[0], X[4 * k + 1] * g0[1]), ay = cvtpk(X[4 * k + 2] * g0[2], X[4 * k + 3] * g0[3]); \
                unsigned bx_ = cvtpk(X[4 * k + 4] * g1[0], X[4 * k + 5] * g1[1]), by_ = cvtpk(X[4 * k + 6] * g1[2], X[4 * k + 7] * g1[3]); \
                auto rx = __builtin_amdgcn_permlane32_swap(ax, bx_, false, false); auto ry = __builtin_amdgcn_permlane32_swap(ay, by_, false, false); \
                u32x4 v; v.x = rx[0]; v.y = ry[0]; v.z = rx[1]; v.w = ry[1]; \
                *(u32x4*)(mp + (COFF) + 8 * k) = v; } } while (0)
        {
            bf16x8 wX[8], wY[8]; s16x4 uX0[4], uX1[4], uY0[4], uY1[4]; float bX, bY;
#define MX_SG_LOAD(ib_, W_, U0_, U1_, B_) do { \
                const bf16_t* wp = a.Wsb + (size_t)(w * 4 + (ib_)) * 8 * 512 + (l32 * 2 + hi) * 8; _Pragma("unroll") for (int kk = 0; kk < 8; ++kk) W_[kk] = *(const bf16x8*)(wp + kk * 512); \
                const bf16_t* up = a.U + ((size_t)((tok0 >> 5) + (ib_)) * 8 + w) * 4 * 512 + (l32 * 2 + hi) * 8; \
                _Pragma("unroll") for (int q = 0; q < 2; ++q) { const bf16x8 ua = *(const bf16x8*)(up + q * 512), ub = *(const bf16x8*)(up + (2 + q) * 512); \
                    U0_[2 * q] = __builtin_shufflevector(ua, ua, 0, 1, 2, 3); U0_[2 * q + 1] = __builtin_shufflevector(ua, ua, 4, 5, 6, 7); U1_[2 * q] = __builtin_shufflevector(ub, ub, 0, 1, 2, 3); U1_[2 * q + 1] = __builtin_shufflevector(ub, ub, 4, 5, 6, 7); } \
                B_ = a.bsp[w * 128 + 32 * (ib_) + l32]; } while (0)
#define MX_SG_RUN(ib_, W_, U0_, U1_, B_) do { f32x16 sg0 = zero16, sg1 = zero16; \
                _Pragma("unroll") for (int kk = 0; kk < 8; ++kk) { sg0 = MFMA32(gnl[kk * 64], W_[kk], sg0); sg1 = MFMA32(gnl[(8 + kk) * 64], W_[kk], sg1); }     \
                float pb = 0.f; \
                _Pragma("unroll") for (int g4 = 0; g4 < 4; ++g4) _Pragma("unroll") for (int e = 0; e < 4; ++e) { \
                    sg0[4 * g4 + e] = bf2f(U0_[g4][e]) * (sg0[4 * g4 + e] + B_); sg1[4 * g4 + e] = bf2f(U1_[g4][e]) * (sg1[4 * g4 + e] + B_); \
                    pb += sg0[4 * g4 + e] * sg0[4 * g4 + e] + sg1[4 * g4 + e] * sg1[4 * g4 + e]; } \
                pb = half_sum(pb); if (hi == 0) part[(32 * (ib_) + l32) * 16 + 8 + w] = pb; \
                bf16_t* mp = a.mixed + (size_t)(tok0 + 32 * (ib_) + l32) * 1024 + 64 * w + 8 * hi; \
                MX_STORE2(sg0, (gl + 512), 512); MX_STORE2(sg1, (gl + 512 + 32), 512 + 32); } while (0)
            MX_SG_LOAD(0, wX, uX0, uX1, bX); MX_SG_LOAD(1, wY, uY0, uY1, bY);
            MX_SG_RUN(0, wX, uX0, uX1, bX); MX_SG_LOAD(2, wX, uX0, uX1, bX);
            MX_SG_RUN(1, wY, uY0, uY1, bY); MX_SG_LOAD(3, wY, uY0, uY1, bY);
            MX_SG_RUN(2, wX, uX0, uX1, bX);
            MX_SG_RUN(3, wY, uY0, uY1, bY);
#undef MX_SG_LOAD
#undef MX_SG_RUN
        }
        const bf16_t* Kw = a.K + (size_t)w * 4 * 512 + (l32 * 2 + hi) * 8;
        const bf16_t* vrow = a.Vt + (size_t)w * 4 * 512 + (l32 * 2 + hi) * 8;
#define MX_LOADKV(kf, va, k0_) do { const int kc_ = (k0_) < 0 ? 0 : (k0_); const size_t tb_ = ((seq0 + (size_t)kc_) >> 5) * 16384; const bf16_t* kp_ = Kw + tb_; const bf16_t* vp_ = vrow + tb_; \
            _Pragma("unroll") for (int kk = 0; kk < 4; ++kk) kf[kk] = *(const bf16x8*)(kp_ + kk * 512); \
            _Pragma("unroll") for (int db = 0; db < 2; ++db) _Pragma("unroll") for (int s = 0; s < 2; ++s) va[db][s] = *(const bf16x8*)(vp_ + (2 * db + s) * 512); } while (0)
#define MX_VF(va, db, s) va[db][s]
#define MX_TILE(kf, va, DIAG) do { \
            f32x16 S = zero16; \
            _Pragma("unroll") for (int kk = 0; kk < 4; ++kk) S = MFMA32(kf[kk], qf[kk], S); \
            f32x4 f4[4], be4[4];                                    \
            _Pragma("unroll") for (int g = 0; g < 4; ++g) { \
                const f32x4 sv = {S[4 * g], S[4 * g + 1], S[4 * g + 2], S[4 * g + 3]}; \
                const f32x4 e4 = pg8::exp2_4(sv); f4[g] = pg8::rcp_4(e4 + 1.0f); be4[g] = 1.0f - f4[g]; }     \
            if (DIAG) { _Pragma("unroll") for (int g = 0; g < 4; ++g) _Pragma("unroll") for (int e = 0; e < 4; ++e) { const int key = e + 8 * g + 4 * hi; if (key >= l32) { f4[g][e] = 1.f; be4[g][e] = 0.f; } } } \
            f32x4 c4[4]; float T[4]; \
            _Pragma("unroll") for (int g = 0; g < 4; ++g) { const float p2 = f4[g][3], p1 = p2 * f4[g][2], p0 = p1 * f4[g][1]; T[g] = p0 * f4[g][0]; c4[g] = (f32x4){p0, p1, p2, 1.f}; } \
            float Ta[4], Tb[4]; \
            _Pragma("unroll") for (int g = 0; g < 4; ++g) { auto rr = __builtin_amdgcn_permlane32_swap(__float_as_uint(T[g]), __float_as_uint(T[g]), false, false); Ta[g] = __uint_as_float(rr[0]); Tb[g] = __uint_as_float(rr[1]); } \
            const float E6 = Tb[3], E5 = E6 * Ta[3], E4 = E5 * Tb[2], E3 = E4 * Ta[2], E2 = E3 * Tb[1], E1 = E2 * Ta[1], E0 = E1 * Tb[0], total = E0 * Ta[0]; \
            float Eg[4]; Eg[0] = hi ? E1 : E0; Eg[1] = hi ? E3 : E2; Eg[2] = hi ? E5 : E4; Eg[3] = hi ? 1.f : E6; \
            f32x4 A4[4]; \
            _Pragma("unroll") for (int g = 0; g < 4; ++g) A4[g] = be4[g] * (c4[g] * (carry * Eg[g])); \
            carry *= total; \
            u32x4 w0, w1; \
            w0.x = cvtpk(A4[0][0], A4[0][1]); w0.y = cvtpk(A4[0][2], A4[0][3]); w0.z = cvtpk(A4[1][0], A4[1][1]); w0.w = cvtpk(A4[1][2], A4[1][3]); \
            w1.x = cvtpk(A4[2][0], A4[2][1]); w1.y = cvtpk(A4[2][2], A4[2][3]); w1.z = cvtpk(A4[3][0], A4[3][1]); w1.w = cvtpk(A4[3][2], A4[3][3]); \
            const bf16x8 ps0 = __builtin_bit_cast(bf16x8, w0), ps1 = __builtin_bit_cast(bf16x8, w1); \
            o0 = MFMA32(MX_VF(va, 0, 0), ps0, o0); o0 = MFMA32(MX_VF(va, 0, 1), ps1, o0); \
            o1 = MFMA32(MX_VF(va, 1, 0), ps0, o1); o1 = MFMA32(MX_VF(va, 1, 1), ps1, o1); } while (0)
        bf16x8 qf[4], kfA[4], kfB[4], kfC[4], vaA[2][2], vaB[2][2], vaC[2][2];
#define MX_PRELOAD(ib_) do { const int q0_ = s0 + 32 * (ib_); \
            { const bf16_t* qp = a.Q + ((seq0 + (size_t)q0_) >> 5) * 16384 + (size_t)w * 4 * 512 + (l32 * 2 + hi) * 8; _Pragma("unroll") for (int kk = 0; kk < 4; ++kk) qf[kk] = *(const bf16x8*)(qp + kk * 512); } \
            MX_LOADKV(kfA, vaA, q0_); MX_LOADKV(kfB, vaB, q0_ - 32); } while (0)
        MX_PRELOAD(0);
#pragma unroll 1
        for (int ib = 0; ib < 4; ++ib) {
            const int q0 = s0 + 32 * ib;
            f32x16 o0 = zero16, o1 = zero16;
            {
                float carry = 1.f; int k0 = q0;
                for (;;) {
                    MX_LOADKV(kfC, vaC, k0 - 64);
                    MX_TILE(kfA, vaA, k0 == q0);
                    if (k0 < 32 || !__any(carry >= 1e-37f)) break;
                    k0 -= 32;
                    MX_LOADKV(kfA, vaA, k0 - 64);
                    MX_TILE(kfB, vaB, false);
                    if (k0 < 32 || !__any(carry >= 1e-37f)) break;
                    k0 -= 32;
                    MX_LOADKV(kfB, vaB, k0 - 64);
                    MX_TILE(kfC, vaC, false);
                    if (k0 < 32 || !__any(carry >= 1e-37f)) break;
                    k0 -= 32;
                }
            }
            float pa = 0.f;
#pragma unroll
            for (int r = 0; r < 16; ++r) pa += o0[r] * o0[r] + o1[r] * o1[r];
            pa = half_sum(pa); if (hi == 0) part[(32 * ib + l32) * 16 + w] = pa;
            if (ib < 3) MX_PRELOAD(ib + 1);
            bf16_t* mp = a.mixed + (size_t)(tok0 + 32 * ib + l32) * 1024 + 64 * w + 8 * hi;
            MX_STORE2(o0, gl, 0); MX_STORE2(o1, (gl + 32), 32);
        }
#undef MX_STORE2
#undef MX_LOADKV
#undef MX_PRELOAD
#undef MX_VF
#undef MX_TILE
        __syncthreads();
        if (tid < 128) { const MX_LAS f32x4* pp = (const MX_LAS f32x4*)(part + tid * 16); const f32x4 pa4 = pp[0] + pp[1], pb4 = pp[2] + pp[3];
            const float rA = __builtin_amdgcn_rsqf(((pa4[0] + pa4[1]) + (pa4[2] + pa4[3])) * (1.0f / 512.0f) + NORM_EPS), rB = __builtin_amdgcn_rsqf(((pb4[0] + pb4[1]) + (pb4[2] + pb4[3])) * (1.0f / 512.0f) + NORM_EPS);
            f32x2_t o; o.x = rA / rB; o.y = rB; *(f32x2_t*)(a.rowsc + (size_t)(tok0 + tid) * 2) = o; }
    }
}
#undef MFMA32
}

#ifndef MK_N_LAUNCHES
#define MK_N_LAUNCHES 1
#endif
constexpr int NWAVES = 8;
constexpr int MTOK = pg8::MTOK, DM = 1024, NTOK1 = 1536, NCH1 = 1024, DFF = 2816, NGU = 2 * DFF;
constexpr size_t MiB = 1u << 20;
constexpr size_t WS_WTOK = 2 * MiB, WS_WCH = 5 * MiB, WS_WOUT = 7 * MiB, WS_WGU = 9 * MiB, WS_WDN = 20 * MiB, WS_WSB = 26 * MiB, WS_RSTD1 = 27 * MiB, WS_RSTD2 = 27 * MiB + 512 * 1024, WS_GSS = 28 * MiB, WS_SS2 = 29 * MiB, WS_ROWSC = 33 * MiB;
constexpr size_t WS_XB = 64 * MiB, WS_Q = 192 * MiB, WS_K = 256 * MiB, WS_U = 320 * MiB, WS_VT = 384 * MiB, WS_GT = 452 * MiB, WS_MIXED = 520 * MiB, WS_X1B = 648 * MiB, WS_END = 776 * MiB;
constexpr size_t WS_ACT = 64 * MiB;
static_assert(WS_K - WS_Q == WS_U - WS_K, "q | k | u outputs equally spaced");
static_assert(WS_VT + (size_t)512 * pg8::VPITCH * 2 <= WS_GT && WS_GT + (size_t)512 * pg8::VPITCH * 2 <= WS_MIXED, "V^T / G^T slots");
static_assert(WS_WGU + (size_t)NGU * DM * 2 <= WS_WDN && WS_WDN + (size_t)DM * DFF * 2 <= WS_WSB && WS_SS2 + (size_t)MTOK * 64 <= WS_XB && WS_ACT + (size_t)MTOK * DFF * 2 <= WS_MIXED, "d_ws map");
constexpr int RING_BYTES = 131072;
constexpr int LDS_BYTES = 147456;

#define GAS __attribute__((address_space(1)))
#define LAS __attribute__((address_space(3)))
typedef unsigned short bf16;
typedef unsigned v4u __attribute__((ext_vector_type(4)));
typedef float f32x4 __attribute__((ext_vector_type(4)));
#define LDS_WAIT() asm volatile("s_waitcnt lgkmcnt(0)" ::: "memory")
__device__ __forceinline__ unsigned f2bf(float f) { unsigned u = __builtin_bit_cast(unsigned, f); return (u + 0x7fffu + ((u >> 16) & 1u)) >> 16; }
__device__ __forceinline__ unsigned pk2(float lo, float hi) { return f2bf(lo) | (f2bf(hi) << 16); }
__device__ __forceinline__ float wave_sum(float v) {
#pragma unroll
    for (int o = 1; o < 64; o <<= 1) v += __shfl_xor(v, o);
    return v;
}
__device__ __forceinline__ void tr_item(const float* W, int ldw, int k0, int n_src0, const float* scale, bf16* WT, int ldt, int n_dst0, LAS float* scr, int lane) {
#pragma unroll 8
    for (int i = 0; i < 32; ++i) { const int kk = 2 * i + (lane >> 5); const float s = scale ? scale[k0 + kk] : 1.0f; scr[kk * 33 + (lane & 31)] = W[(size_t)(k0 + kk) * ldw + n_src0 + (lane & 31)] * s; }
    LDS_WAIT(); asm volatile("" ::: "memory");
    const int c = lane & 7;
#pragma unroll
    for (int j = 0; j < 4; ++j) { const int n = (lane >> 3) + 8 * j; const LAS float* s = scr + (8 * c) * 33 + n;
        v4u o; o.x = pk2(s[0 * 33], s[1 * 33]); o.y = pk2(s[2 * 33], s[3 * 33]); o.z = pk2(s[4 * 33], s[5 * 33]); o.w = pk2(s[6 * 33], s[7 * 33]);
        *(v4u*)(WT + (size_t)(n_dst0 + n) * ldt + k0 + 8 * c) = o; }
    LDS_WAIT(); asm volatile("" ::: "memory");
}

#define RLX_AGENT __ATOMIC_RELAXED, __HIP_MEMORY_SCOPE_AGENT
#define XB_TMO      128
#define XB_XCNT(j)  (256  + 64 * (j))
#define XB_XSUB(j)  (1280 + 64 * (j))
#define XB_XGEN(j)  (2304 + 64 * (j))
#define XB_TOP      3328
#define XB_TOPGEN   3392
#define XCD_BAR_WORDS 3456
#define XB_SPIN_CAP (1u << 18)

__device__ __forceinline__ unsigned xb_ld(unsigned* p)              { return __hip_atomic_load(p, __ATOMIC_RELAXED, __HIP_MEMORY_SCOPE_AGENT); }
__device__ __forceinline__ unsigned xb_add(unsigned* p, unsigned v) { return __hip_atomic_fetch_add(p, v, __ATOMIC_RELAXED, __HIP_MEMORY_SCOPE_AGENT); }
__device__ __forceinline__ unsigned xb_xcc_id() { return (unsigned)__builtin_amdgcn_s_getreg((3 << 11) | 20) & 0xFu; }
#define XB_SPIN(cond, bar) do { unsigned _sp = 0; while (cond) { __builtin_amdgcn_s_sleep(1); \
    if ((++_sp & 255u) == 0u) { if (xb_ld(&(bar)[XB_TMO])) break; if (_sp > XB_SPIN_CAP) { atomicAdd(&(bar)[XB_TMO], 1u); break; } } } } while (0)

struct XcdBarrier {
    unsigned* bar; unsigned x;
    volatile LAS unsigned* st;
};

__device__ __forceinline__ XcdBarrier xcd_barrier_post(unsigned* bar, volatile LAS unsigned* st) {
    XcdBarrier b; b.bar = bar; b.x = xb_xcc_id(); b.st = st;
    if (threadIdx.x == 0) (void)xb_add(&bar[XB_XCNT(b.x)], 1u);
    return b;
}
__device__ __forceinline__ void xcd_barrier_complete(unsigned* bar, unsigned x, unsigned& nloc, unsigned& nx) {
    const unsigned G = gridDim.x * gridDim.y * gridDim.z;
    unsigned sum, cnt, mine, sp = 0u;
    for (;;) {
        sum = 0u; cnt = 0u; mine = 0u;
#pragma unroll
        for (unsigned j = 0; j < 16; ++j) { const unsigned c = xb_ld(&bar[XB_XCNT(j)]); sum += c; cnt += (c > 0u) ? 1u : 0u; mine = (j == x) ? c : mine; }
        if (sum == G) break;
        __builtin_amdgcn_s_sleep(1);
        if ((++sp & 255u) == 0u) { if (xb_ld(&bar[XB_TMO])) break; if (sp > XB_SPIN_CAP) { atomicAdd(&bar[XB_TMO], 1u); break; } }
    }
    nloc = mine > 0u ? mine : 1u; nx = cnt > 0u ? cnt : 1u;
}

__device__ __forceinline__ void xcd_barrier(const XcdBarrier& b) {
    asm volatile("s_waitcnt vmcnt(0)" ::: "memory");
    __syncthreads();
    if (threadIdx.x == 0) {
        unsigned* bar = b.bar;
        __builtin_amdgcn_s_waitcnt(0);
        unsigned nloc = b.st[0], nx = b.st[1];
        if (nloc == 0u) { xcd_barrier_complete(bar, b.x, nloc, nx); b.st[0] = nloc; b.st[1] = nx; }
        const unsigned old = xb_add(&bar[XB_XSUB(b.x)], 1u);
        const unsigned gen = old / nloc;
        if (old + 1u == (gen + 1u) * nloc) {
            __builtin_amdgcn_fence(__ATOMIC_RELEASE, "agent");
            asm volatile("s_waitcnt vmcnt(0)" ::: "memory");
            const unsigned og = xb_add(&bar[XB_TOP], 1u);
            const unsigned tg = og / nx;
            if (og + 1u == (tg + 1u) * nx) xb_add(&bar[XB_TOPGEN], 1u);
            else XB_SPIN(xb_ld(&bar[XB_TOPGEN]) == tg, bar);
            __builtin_amdgcn_fence(__ATOMIC_ACQUIRE, "agent");
            xb_add(&bar[XB_XGEN(b.x)], 1u);
            asm volatile("s_waitcnt vmcnt(0)" ::: "memory");
        } else {
            XB_SPIN(xb_ld(&bar[XB_XGEN(b.x)]) == gen, bar);
            __builtin_amdgcn_fence(__ATOMIC_ACQUIRE, "agent");
            asm volatile("s_waitcnt vmcnt(0)" ::: "memory");
        }
    }
    __syncthreads();
}

struct Args { const float* in[15]; float* out; unsigned char* ws; int ph_lo, ph_hi; };

__global__ void __launch_bounds__(NWAVES * 64, 2) fused_fwd(Args args) {
    extern __shared__ __attribute__((aligned(16))) unsigned char lds_raw[];
    LAS unsigned char* lds = (LAS unsigned char*)lds_raw;
    cg::grid_group grid = cg::this_grid();
    const int tid = threadIdx.x, lane = tid & 63, wave = __builtin_amdgcn_readfirstlane(tid >> 6);
    const int G = gridDim.x, bx = blockIdx.x;
    unsigned char* ws = args.ws;
    const float* x = args.in[0]; const float* attn_g = args.in[1]; const float* w_in = args.in[2]; const float* q_g = args.in[3]; const float* k_g = args.in[4]; const float* sgu_g = args.in[5];
    const float* w_sp = args.in[6]; const float* b_sp = args.in[7]; const float* sbo_g = args.in[8]; const float* sguo_g = args.in[9]; const float* w_out = args.in[10]; const float* ffn_g = args.in[11];
    const float* w_gate = args.in[12]; const float* w_up = args.in[13]; const float* w_down = args.in[14];
    bf16* Wtok = (bf16*)(ws + WS_WTOK); bf16* Wch = (bf16*)(ws + WS_WCH); bf16* Wout = (bf16*)(ws + WS_WOUT); bf16* Wgu = (bf16*)(ws + WS_WGU); bf16* Wdn = (bf16*)(ws + WS_WDN); bf16* Wsb = (bf16*)(ws + WS_WSB);
    float* rstd1 = (float*)(ws + WS_RSTD1); float* rstd2 = (float*)(ws + WS_RSTD2); float* rowsc = (float*)(ws + WS_ROWSC); float* gss = (float*)(ws + WS_GSS); float* ss2 = (float*)(ws + WS_SS2);
    bf16* XB = (bf16*)(ws + WS_XB); bf16* Qb = (bf16*)(ws + WS_Q); bf16* Kb = (bf16*)(ws + WS_K); bf16* Ub = (bf16*)(ws + WS_U); bf16* Vt = (bf16*)(ws + WS_VT); bf16* Gt = (bf16*)(ws + WS_GT);
    bf16* MIXED = (bf16*)(ws + WS_MIXED); bf16* X1B = (bf16*)(ws + WS_X1B); bf16* ACT = (bf16*)(ws + WS_ACT);
    const int lo = args.ph_lo, hi = args.ph_hi;
    for (int u = tid; u < (LDS_BYTES - RING_BYTES) / 4; u += NWAVES * 64) ((LAS unsigned*)(lds + RING_BYTES))[u] = 0u;
    __syncthreads();
    XcdBarrier bar; bar.bar = (unsigned*)ws; bar.x = 0; bar.st = nullptr;
    if (hi - lo > 1) bar = xcd_barrier_post((unsigned*)ws, (volatile LAS unsigned*)(lds + RING_BYTES + 352));
#define IN(k) (lo <= (k) && (k) < hi)
#define SEAM(k) do { if (IN(k) && IN((k) + 1)) { if (lo < 0) grid.sync();   else xcd_barrier(bar); } } while (0)

    if (IN(0)) {
        LAS float* scr = (LAS float*)(lds + wave * 16384);
        const int gw = bx * NWAVES + wave, NGW = G * NWAVES;
        constexpr int I1 = 48 * 16, I2 = 32 * 16, I3 = 32 * 16, I4 = 88 * 16, I5 = 88 * 16, I6 = 32 * 44, NITEMS = I1 + I2 + I3 + I4 + I5 + I6;
        for (int it = gw; it < NITEMS; it += NGW) {
            int r = it;
            if (r < I1) { const int kb = r / 48, nb = r % 48, region = nb / 16, cb = nb % 16; const int src = (region == 0 ? 0 : (region == 1 ? 512 : 1536)) + 32 * cb;
                const int dst = 512 * region + 256 * (cb / 8) + 128 * (cb & 1) + 32 * ((cb % 8) / 2);
                tr_item(w_in, 2560, 64 * kb, src, attn_g, Wtok, DM, dst, scr, lane); continue; } r -= I1;
            if (r < I2) { const int kb = r / 32, nb = r % 32; const int src = (nb < 16 ? 1024 : 2048) + 32 * (nb % 16);
                tr_item(w_in, 2560, 64 * kb, src, attn_g, Wch, DM, 32 * nb, scr, lane); continue; } r -= I2;
            if (r < I3) { const int kb = r / 32, nb = r % 32; tr_item(w_out, DM, 64 * kb, 32 * nb, nullptr, Wout, DM, 32 * nb, scr, lane); continue; } r -= I3;
            if (r < I4) { const int kb = r / 88, nb = r % 88; tr_item(w_gate, DFF, 64 * kb, 32 * nb, ffn_g, Wgu, DM, 256 * (nb / 4) + 32 * (nb % 4), scr, lane); continue; } r -= I4;
            if (r < I5) { const int kb = r / 88, nb = r % 88; tr_item(w_up, DFF, 64 * kb, 32 * nb, ffn_g, Wgu, DM, 256 * (nb / 4) + 128 + 32 * (nb % 4), scr, lane); continue; } r -= I5;
            { const int kb = r / 32, nb = r % 32; tr_item(w_down, DM, 64 * kb, 32 * nb, nullptr, Wdn, DFF, 32 * nb, scr, lane); }
        }
        for (int i = bx * (NWAVES * 64) + tid; i < 8 * 128 * 128; i += G * NWAVES * 64) { const int ii = (i >> 7) & 127, jj = i & 127; Wsb[(((((i >> 14) * 4 + (ii >> 5)) * 8 + (jj >> 4)) * 32 + (ii & 31)) * 2 + ((jj >> 3) & 1)) * 8 + (jj & 7)] = (bf16)(((jj >> 6) <= (ii >> 6)) ? f2bf(w_sp[i]) : 0u); }
        for (int m0 = 4 * gw; m0 < MTOK; m0 += 4 * NGW) {
            f32x4 v[4][4]; float s[4];
#pragma unroll
            for (int q = 0; q < 4; ++q) { const f32x4* xr = (const f32x4*)(x + (size_t)(m0 + q) * DM) + lane;
#pragma unroll
                for (int j = 0; j < 4; ++j) v[q][j] = xr[64 * j]; }
#pragma unroll
            for (int q = 0; q < 4; ++q) { float t = 0.f;
#pragma unroll
                for (int j = 0; j < 4; ++j) t += (v[q][j].x * v[q][j].x + v[q][j].y * v[q][j].y) + (v[q][j].z * v[q][j].z + v[q][j].w * v[q][j].w);
                s[q] = wave_sum(t); }
            if (lane < 4) rstd1[m0 + lane] = __builtin_amdgcn_rsqf((lane == 0 ? s[0] : lane == 1 ? s[1] : lane == 2 ? s[2] : s[3]) * (1.0f / DM) + pg8::NORM_EPS);
#pragma unroll
            for (int q = 0; q < 4; ++q) { unsigned long long* o8 = (unsigned long long*)(XB + (size_t)(m0 + q) * DM) + lane;
#pragma unroll
                for (int j = 0; j < 4; ++j) o8[64 * j] = (unsigned long long)pk2(v[q][j].x, v[q][j].y) | ((unsigned long long)pk2(v[q][j].z, v[q][j].w) << 32); }
        }
    }
    SEAM(0);

    if (IN(1)) {
        { pg8::Gemm g{XB, Wtok, MTOK, NTOK1, DM}; pg8::StaticOrder S; S.init(MTOK, NTOK1, G, bx);
          pg8::EpiTok1 E{Qb, (size_t)(WS_K - WS_Q) / 2, rstd1, q_g, k_g};
          pg8::gemm_phase<pg8::EpiTok1, pg8::StaticOrder, true, true>(lds, g, S, E); }
        { pg8::Gemm g{Wch, XB, NCH1, MTOK, DM}; pg8::StaticOrder S; S.init(NCH1, MTOK, G, bx);
          pg8::EpiCh1 E{Vt, Gt, rstd1, gss};
          pg8::gemm_phase<pg8::EpiCh1, pg8::StaticOrder, true, true>(lds, g, S, E); }
    }
    SEAM(1);

    if (IN(2)) {
        const mixp::MixArgs ma{Qb, Kb, Ub, Vt, Gt, Wsb, gss, b_sp, sgu_g, sbo_g, sguo_g, MIXED, rowsc};
        mixp::mix_phase(lds, ma, G, bx);
    }
    SEAM(2);

    if (IN(3)) {
        pg8::Gemm g{MIXED, Wout, MTOK, DM, DM}; pg8::StaticOrder S; S.init(MTOK, DM, G, bx);
        pg8::EpiOut E{XB, X1B, ss2, (const LAS float*)(lds + pg8::STAGE_BYTES + 2048) + 256};
        pg8::gemm_phase<pg8::EpiOut, pg8::StaticOrder, true, true, true>(lds, g, S, E, rowsc);
    }
    SEAM(3);

    if (IN(4)) {
        pg8::Gemm g{X1B, Wgu, MTOK, NGU, DM}; pg8::StaticOrder S; S.init(MTOK, NGU, G, bx);
        pg8::gu_prepare_rstd(S, ss2, rstd2);
        pg8::EpiGU E{ACT, rstd2, DFF};
        pg8::gemm_phase<pg8::EpiGU, pg8::StaticOrder, true, true>(lds, g, S, E);
    }
    SEAM(4);

    if (IN(5)) {
        pg8::Gemm g{ACT, Wdn, MTOK, DM, DFF}; pg8::StaticOrder S; S.init(MTOK, DM, G, bx);
        pg8::EpiDown E{X1B, args.out};
        pg8::gemm_phase<pg8::EpiDown, pg8::StaticOrder, true, true>(lds, g, S, E);
    }
#undef IN
#undef SEAM
}

extern "C" void kernel_launch(void* const* d_in, const int* in_sizes, int n_in, void* d_out, int out_size, void* d_ws, size_t ws_size, hipStream_t stream) {
    static int grid = 0;
    if (grid == 0) {
        if (n_in != 15 || out_size != MTOK * DM || ws_size < WS_END) { fprintf(stderr, "kernel_launch: unexpected shapes (n_in %d, out %d, ws %zu)\n", n_in, out_size, ws_size); grid = -1; return; }
        int dev = 0, cus = 0, per_cu = 0;
        (void)hipGetDevice(&dev); (void)hipDeviceGetAttribute(&cus, hipDeviceAttributeMultiprocessorCount, dev);
        if (hipFuncSetAttribute((const void*)fused_fwd, hipFuncAttributeMaxDynamicSharedMemorySize, LDS_BYTES) != hipSuccess) { fprintf(stderr, "kernel_launch: hipFuncSetAttribute failed\n"); grid = -1; return; }
        if (hipOccupancyMaxActiveBlocksPerMultiprocessor(&per_cu, (const void*)fused_fwd, NWAVES * 64, LDS_BYTES) != hipSuccess || per_cu < 1) per_cu = 1;
        (void)hipGetLastError();
        grid = cus * per_cu;
    }
    if (grid < 0) return;
    if (hipMemsetAsync(d_ws, 0, 16384, stream) != hipSuccess) { fprintf(stderr, "kernel_launch: memset of the barrier words failed\n"); return; }
    Args a{};
    for (int i = 0; i < 15; ++i) a.in[i] = (const float*)d_in[i];
    a.out = (float*)d_out; a.ws = (unsigned char*)d_ws;
#if MK_N_LAUNCHES == 1
    a.ph_lo = 0; a.ph_hi = 6;
    void* params[] = {&a};
    const hipError_t e = hipLaunchCooperativeKernel((const void*)fused_fwd, dim3(grid), dim3(NWAVES * 64), params, LDS_BYTES, stream);
    if (e != hipSuccess) fprintf(stderr, "kernel_launch: cooperative launch failed: %s (grid %d)\n", hipGetErrorString(e), grid);
#else
    for (int p = 0; p < 6; ++p) { a.ph_lo = p; a.ph_hi = p + 1; hipLaunchKernelGGL(fused_fwd, dim3(grid), dim3(NWAVES * 64), LDS_BYTES, stream, a); }
#endif
}
```

```cpp
#include <hip/hip_runtime.h>
#include <hip/hip_cooperative_groups.h>
#include <cstdio>
#include <cstdint>
namespace cg = cooperative_groups;
#define MK_N_LAUNCHES 1
namespace pg8 {
#define PG8_LAS __attribute__((address_space(3)))
typedef unsigned short bf16_t;
typedef short bf16x8 __attribute__((ext_vector_type(8)));
typedef float f32x4 __attribute__((ext_vector_type(4)));
typedef unsigned u32x4 __attribute__((ext_vector_type(4)));
constexpr int BM = 256, BK = 64, HALF = 128, HTB = HALF * BK * 2  , STAGE_BYTES = 8 * HTB, NXCD = 8, WGM = 8;

__host__ __device__ __forceinline__ int lds_byte(int r, int c) { const int st = (r >> 4) * 2 + (c >> 5), rr = r & 15, cc = c & 31, ob = rr * 64 + cc * 2; return st * 1024 + (ob ^ (((ob >> 9) & 1) << 5)); }
__host__ __device__ __forceinline__ void stage_rc(int b, int& R, int& C) { const int st = b / 1024, sb = b % 1024, swz = sb ^ (((sb >> 9) & 1) << 5); R = (st >> 1) * 16 + swz / 64; C = (st & 1) * 32 + (swz % 64) / 2; }
__host__ __device__ __forceinline__ int perm32(int rho) { const int n = rho >> 4, i = rho & 15; return 8 * (i >> 2) + 4 * n + (i & 3); }

struct Unit { int pm, pn; };
struct Gemm { const bf16_t* A; const bf16_t* Bt; int M, N, K; };

struct StaticOrder {
    int nM, nN, nwg, G, c;
    __host__ __device__ void init(int M, int N, int G_, int c_) { nM = M / BM; nN = N / BM; nwg = nM * nN; G = G_; c = c_; }
    __host__ __device__ bool next(int i, Unit& u) const {
        const long L = (long)i * G + c; if (L >= nwg) return false;
        int wgid = (int)L; { const int q = nwg / NXCD, r = nwg % NXCD, xcd = wgid % NXCD, off = wgid / NXCD; wgid = (xcd < r ? xcd * (q + 1) : r * (q + 1) + (xcd - r) * q) + off; }
        const int nig = WGM * nN, gid = wgid / nig, fm = gid * WGM, gsz = (nM - fm) < WGM ? (nM - fm) : WGM;
        u.pm = fm + ((wgid % nig) % gsz); u.pn = (wgid % nig) / gsz; return true;
    }
    __device__ __forceinline__ void a_ready(const Unit&) const {}
    __device__ __forceinline__ void done(const Unit&) const {}
};

__device__ __forceinline__ unsigned cvt_pk_bf16(float lo, float hi) { unsigned r; asm volatile("v_cvt_pk_bf16_f32 %0, %1, %2" : "=v"(r) : "v"(lo), "v"(hi)); return r; }
typedef float f32x2 __attribute__((ext_vector_type(2)));
constexpr int MTOK = 65536;
constexpr int VPITCH = MTOK + 2112;
constexpr float NORM_EPS = 1e-6f;
constexpr float QSCALE = 0.125f * 1.4426950408889634f;
__device__ __forceinline__ f32x4 exp2_4(const f32x4 t) { return (f32x4){__builtin_amdgcn_exp2f(t[0]), __builtin_amdgcn_exp2f(t[1]), __builtin_amdgcn_exp2f(t[2]), __builtin_amdgcn_exp2f(t[3])}; }
__device__ __forceinline__ f32x4 rcp_4(const f32x4 t) { return (f32x4){__builtin_amdgcn_rcpf(t[0]), __builtin_amdgcn_rcpf(t[1]), __builtin_amdgcn_rcpf(t[2]), __builtin_amdgcn_rcpf(t[3])}; }
__device__ __forceinline__ f32x4 gelu_tanh4(const f32x4 x) {
    const f32x4 x2 = x * x, p = x2 * (-0.10294324f) + (-2.3022082f), t = x * p;
    return x * rcp_4(exp2_4(t) + 1.0f);
}
typedef unsigned u32x2 __attribute__((ext_vector_type(2)));
__device__ __forceinline__ u32x4 pack8(const f32x4 a, const f32x4 b) { u32x4 w; w.x = cvt_pk_bf16(a[0], a[1]); w.y = cvt_pk_bf16(a[2], a[3]); w.z = cvt_pk_bf16(b[0], b[1]); w.w = cvt_pk_bf16(b[2], b[3]); return w; }
__device__ __forceinline__ float sumsq4(const f32x4 a) { return (a[0] * a[0] + a[1] * a[1]) + (a[2] * a[2] + a[3] * a[3]); }

struct EpiTok1 {
    static constexpr bool PERM = true, AFTER_DRAIN = false;
    bf16_t* Q; size_t kind_stride; const float* rstd1; const float* qg; const float* kg;
    __device__ __forceinline__ void operator()(const f32x4 (&acc)[2][2][4][2], const Unit& u, int wr, int wc, int fr, int fq) const {
        const int kind = u.pn >> 1;
        bf16_t* base = Q + (size_t)kind * kind_stride;
        const int colb = (u.pn & 1) * 256 + wc * 64 + 8 * fq;
        const int row0 = u.pm * BM + wr * 64 + fr;
        f32x4 gv[2][2];
        if (kind < 2) { const float* gp = kind == 0 ? qg : kg; const float sc = kind == 0 ? QSCALE : 1.0f;
#pragma unroll
            for (int bj = 0; bj < 2; ++bj)
#pragma unroll
                for (int n = 0; n < 2; ++n) gv[bj][n] = *(const f32x4*)(gp + 32 * bj + 8 * fq + 4 * n) * sc;
        }
        float r1v[2][4];
#pragma unroll
        for (int ai = 0; ai < 2; ++ai)
#pragma unroll
            for (int m = 0; m < 4; ++m) r1v[ai][m] = rstd1[row0 + ai * HALF + m * 16];
#pragma unroll
        for (int ai = 0; ai < 2; ++ai)
#pragma unroll
            for (int m = 0; m < 4; ++m) {
                const int row = row0 + ai * HALF + m * 16;
                const float r1 = r1v[ai][m];
                f32x4 v[2][2];
#pragma unroll
                for (int bj = 0; bj < 2; ++bj)
#pragma unroll
                    for (int n = 0; n < 2; ++n) v[bj][n] = acc[ai][bj][m][n] * r1;
                if (kind < 2) {
                    float ss = (sumsq4(v[0][0]) + sumsq4(v[0][1])) + (sumsq4(v[1][0]) + sumsq4(v[1][1]));
                    ss += __shfl_xor(ss, 16); ss += __shfl_xor(ss, 32);
                    const float rn = __builtin_amdgcn_rsqf(ss * (1.0f / 64.0f) + NORM_EPS);
#pragma unroll
                    for (int bj = 0; bj < 2; ++bj)
#pragma unroll
                        for (int n = 0; n < 2; ++n) v[bj][n] = v[bj][n] * rn * gv[bj][n];
                } else {
#pragma unroll
                    for (int bj = 0; bj < 2; ++bj)
#pragma unroll
                        for (int n = 0; n < 2; ++n) v[bj][n] = gelu_tanh4(v[bj][n]);
                }
                const int hg = (u.pn & 1) * 4 + wc;
                if (kind < 2) {
                    bf16_t* kp = base + ((size_t)((row >> 5) * 8 + hg) * 4 * 64 + (row & 31) * 2 + (fq & 1)) * 8;
#pragma unroll
                    for (int bj = 0; bj < 2; ++bj) *(u32x4*)(kp + (size_t)(2 * bj + (fq >> 1)) * 512) = pack8(v[bj][0], v[bj][1]);
                } else {
#pragma unroll
                    for (int bj = 0; bj < 2; ++bj) { bf16_t* up = base + ((((size_t)((row >> 5) * 8 + hg) * 4 + 2 * bj + (fq >> 1)) * 64 + (row & 31) * 2) * 2 + (fq & 1)) * 4;
                        u32x2 w0, w1; w0.x = cvt_pk_bf16(v[bj][0][0], v[bj][0][1]); w0.y = cvt_pk_bf16(v[bj][0][2], v[bj][0][3]); w1.x = cvt_pk_bf16(v[bj][1][0], v[bj][1][1]); w1.y = cvt_pk_bf16(v[bj][1][2], v[bj][1][3]);
                        *(u32x2*)up = w0; *(u32x2*)(up + 8) = w1; }
                }
            }
    }
};

struct EpiCh1 {
    static constexpr bool PERM = true, AFTER_DRAIN = false;
    bf16_t* Vt; bf16_t* Gt; const float* rstd1; float* gss;
    __device__ __forceinline__ void operator()(const f32x4 (&acc)[2][2][4][2], const Unit& u, int wr, int wc, int fr, int fq) const {
        const int tok0 = u.pn * BM + wc * 32 + 8 * fq;
        f32x4 rs[2][2];
#pragma unroll
        for (int bj = 0; bj < 2; ++bj)
#pragma unroll
            for (int n = 0; n < 2; ++n) rs[bj][n] = *(const f32x4*)(rstd1 + tok0 + bj * HALF + 4 * n);
        const bool isg = u.pm >= 2;
        const int ch0 = (u.pm & 1) * 256 + wr * 64 + fr;
        f32x4 sq[2][2];
#pragma unroll
        for (int bj = 0; bj < 2; ++bj)
#pragma unroll
            for (int n = 0; n < 2; ++n) sq[bj][n] = (f32x4){0.f, 0.f, 0.f, 0.f};
#pragma unroll
        for (int ai = 0; ai < 2; ++ai)
#pragma unroll
            for (int m = 0; m < 4; ++m) {
#pragma unroll
                for (int bj = 0; bj < 2; ++bj) {
                    f32x4 v0 = acc[ai][bj][m][0] * rs[bj][0], v1 = acc[ai][bj][m][1] * rs[bj][1];
                    if (isg) {
                        v0 = gelu_tanh4(v0); v1 = gelu_tanh4(v1);
                        sq[bj][0] += v0 * v0; sq[bj][1] += v1 * v1;
                    }
                    if (isg) { const int ch = ch0 + ai * HALF + m * 16;
                        *(u32x4*)(Gt + (((((size_t)(u.pn * 2 + bj) * 8 + (ch >> 6)) * 2 + ((ch >> 5) & 1)) * 8 + 2 * wc + (fq >> 1)) * 64 + (ch & 31) * 2 + (fq & 1)) * 8) = pack8(v0, v1); }
                    else {
                        const int ch = ch0 + ai * HALF + m * 16, tb = u.pn * 8 + bj * 4 + wc;
                        bf16_t* vp = Vt + ((size_t)(((tb * 8 + (ch >> 6)) * 2 + ((ch >> 5) & 1)) * 2 + (fq >> 1)) * 64 + (ch & 31) * 2) * 8 + (fq & 1) * 4;
                        u32x2 w0, w1; w0.x = cvt_pk_bf16(v0[0], v0[1]); w0.y = cvt_pk_bf16(v0[2], v0[3]); w1.x = cvt_pk_bf16(v1[0], v1[1]); w1.y = cvt_pk_bf16(v1[2], v1[3]);
                        *(u32x2*)vp = w0; *(u32x2*)(vp + 8) = w1; }
                }
            }
        if (isg) {
#pragma unroll
            for (int bj = 0; bj < 2; ++bj)
#pragma unroll
                for (int n = 0; n < 2; ++n)
#pragma unroll
                    for (int e = 0; e < 4; ++e) { float s = sq[bj][n][e]; s += __shfl_xor(s, 1); s += __shfl_xor(s, 2); s += __shfl_xor(s, 4); s += __shfl_xor(s, 8); sq[bj][n][e] = s; }
            if (fr == 0) { float* gp = gss + (size_t)((u.pm - 2) * 2 + wr) * MTOK + tok0;
#pragma unroll
                for (int bj = 0; bj < 2; ++bj)
#pragma unroll
                    for (int n = 0; n < 2; ++n) *(f32x4*)(gp + bj * HALF + 4 * n) = sq[bj][n]; }
        }
    }
};

struct EpiOut {
    static constexpr bool PERM = true, AFTER_DRAIN = false;
    const bf16_t* xb; bf16_t* x1b; float* ss2; const PG8_LAS float* rbl;
    __device__ __forceinline__ void operator()(const f32x4 (&acc)[2][2][4][2], const Unit& u, int wr, int wc, int fr, int fq) const {
        const int col0 = u.pn * BM + wc * 32 + 8 * fq;
        const int row0 = u.pm * BM + wr * 64 + fr;
#pragma unroll
        for (int ai = 0; ai < 2; ++ai) {
            u32x4 xr[4][2]; float rbv[4];
#pragma unroll
            for (int m = 0; m < 4; ++m) { rbv[m] = rbl[wr * 64 + fr + ai * HALF + m * 16];
#pragma unroll
                for (int bj = 0; bj < 2; ++bj) xr[m][bj] = *(const u32x4*)(xb + (size_t)(row0 + ai * HALF + m * 16) * 1024 + col0 + bj * HALF); }
#pragma unroll
            for (int m = 0; m < 4; ++m) {
                const int row = row0 + ai * HALF + m * 16; const size_t off = (size_t)row * 1024 + col0;
                float ss = 0.f;
#pragma unroll
                for (int bj = 0; bj < 2; ++bj) { const u32x4 r = xr[m][bj];
                    const f32x4 x0 = {__uint_as_float(r.x << 16), __uint_as_float(r.x & 0xffff0000u), __uint_as_float(r.y << 16), __uint_as_float(r.y & 0xffff0000u)};
                    const f32x4 x1 = {__uint_as_float(r.z << 16), __uint_as_float(r.z & 0xffff0000u), __uint_as_float(r.w << 16), __uint_as_float(r.w & 0xffff0000u)};
                    const f32x4 v0 = acc[ai][bj][m][0] * rbv[m] + x0, v1 = acc[ai][bj][m][1] * rbv[m] + x1;
                    *(u32x4*)(x1b + off + bj * HALF) = pack8(v0, v1);
                    ss += sumsq4(v0) + sumsq4(v1);
                }
                ss += __shfl_xor(ss, 16); ss += __shfl_xor(ss, 32);
                if (fq == 0) ss2[(size_t)row * 16 + u.pn * 4 + wc] = ss;
            }
        }
    }
};

struct EpiGU {
    static constexpr bool PERM = true, AFTER_DRAIN = false;
    bf16_t* act; const float* rstd2; int ldc;
    __device__ __forceinline__ void operator()(const f32x4 (&acc)[2][2][4][2], const Unit& u, int wr, int wc, int fr, int fq) const {
        const int col0 = u.pn * HALF + wc * 32 + 8 * fq;
        const int row0 = u.pm * BM + wr * 64 + fr;
        float rv[2][4];
#pragma unroll
        for (int ai = 0; ai < 2; ++ai)
#pragma unroll
            for (int m = 0; m < 4; ++m) rv[ai][m] = rstd2[row0 + ai * HALF + m * 16];
#pragma unroll
        for (int ai = 0; ai < 2; ++ai)
#pragma unroll
            for (int m = 0; m < 4; ++m) {
                const int row = row0 + ai * HALF + m * 16;
                const float r = rv[ai][m], c1 = -1.4426950408889634f * r, r2 = r * r;
                f32x4 o[2];
#pragma unroll
                for (int n = 0; n < 2; ++n) { const f32x4 g = acc[ai][0][m][n], uu = acc[ai][1][m][n];
                    o[n] = (g * uu) * (rcp_4(exp2_4(g * c1) + 1.0f) * r2); }
                *(u32x4*)(act + (size_t)row * ldc + col0) = pack8(o[0], o[1]);
            }
    }
};
template <class Sched> __device__ __forceinline__ void gu_prepare_rstd(const Sched& S, const float* ss2, float* rstd2) {
    const int tid = threadIdx.x; Unit u; int last = -1;
    for (int i = 0; S.next(i, u); ++i) if (u.pm != last) { last = u.pm;
        const int row = u.pm * BM + (tid >> 1); const f32x4* sp = (const f32x4*)(ss2 + (size_t)row * 16) + (tid & 1) * 2;
        const f32x4 p = sp[0] + sp[1]; float s = (p[0] + p[1]) + (p[2] + p[3]); s += __shfl_xor(s, 1);
        if (!(tid & 1)) rstd2[row] = __builtin_amdgcn_rsqf(s * (1.0f / 1024.0f) + NORM_EPS); }
    asm volatile("s_waitcnt vmcnt(0)" ::: "memory"); __syncthreads();
}

struct EpiDown {
    static constexpr bool PERM = true, AFTER_DRAIN = false;
    const bf16_t* x1b; float* out;
    __device__ __forceinline__ void operator()(const f32x4 (&acc)[2][2][4][2], const Unit& u, int wr, int wc, int fr, int fq) const {
        const int col0 = u.pn * BM + wc * 32 + 8 * fq;
        const int row0 = u.pm * BM + wr * 64 + fr;
        u32x4 rr[2][4][2];
#pragma unroll
        for (int ai = 0; ai < 2; ++ai)
#pragma unroll
            for (int m = 0; m < 4; ++m)
#pragma unroll
                for (int bj = 0; bj < 2; ++bj) rr[ai][m][bj] = *(const u32x4*)(x1b + (size_t)(row0 + ai * HALF + m * 16) * 1024 + col0 + bj * HALF);
#pragma unroll
        for (int ai = 0; ai < 2; ++ai)
#pragma unroll
            for (int m = 0; m < 4; ++m) {
                const size_t off = (size_t)(row0 + ai * HALF + m * 16) * 1024 + col0;
#pragma unroll
                for (int bj = 0; bj < 2; ++bj) { const u32x4 r = rr[ai][m][bj];
                    const f32x4 r0 = {__uint_as_float(r.x << 16), __uint_as_float(r.x & 0xffff0000u), __uint_as_float(r.y << 16), __uint_as_float(r.y & 0xffff0000u)};
                    const f32x4 r1 = {__uint_as_float(r.z << 16), __uint_as_float(r.z & 0xffff0000u), __uint_as_float(r.w << 16), __uint_as_float(r.w & 0xffff0000u)};
                    *(f32x4*)(out + off + bj * HALF) = r0 + acc[ai][bj][m][0]; *(f32x4*)(out + off + bj * HALF + 4) = r1 + acc[ai][bj][m][1]; }
            }
    }
};
template <class Epi, class Sched, bool ALIGN_EPI = false, bool SP2 = false, bool MID = false>
__device__ __forceinline__ void gemm_phase(PG8_LAS unsigned char* lds, const Gemm g, const Sched& S, const Epi& E, const float* mid_scale = nullptr) {
    const int tid = threadIdx.x, wid = __builtin_amdgcn_readfirstlane(tid >> 6), lane = tid & 63, wr = wid >> 2, wc = wid & 3, fr = lane & 15, fq = lane >> 4;
    const int K = g.K, nt = K / BK;
    unsigned voffA[2], voffB[2];
#pragma unroll
    for (int i = 0; i < 2; ++i) { int R, C; stage_rc(tid * 16 + i * 8192, R, C); const int Rb = Epi::PERM ? ((R & ~31) + perm32(R & 31)) : R;
        voffA[i] = (unsigned)(R * K + C) * 2u; voffB[i] = (unsigned)(Rb * K + C) * 2u; }
    const size_t kstep = (size_t)(BK * 2);
    const size_t hstep = (size_t)HALF * K * 2;
    const size_t tstep = 2 * hstep;
    const unsigned ldsw = (unsigned)wid * 1024u;
    const int aoff = lds_byte(wr * 64 + fr, fq * 8), boff = lds_byte(wc * 32 + fr, fq * 8);
#define PG8_SA(b, h) (((b) * 2 + (h)) * HTB)
#define PG8_SB(b, h) ((4 + (b) * 2 + (h)) * HTB)
#define PG8_STAGE(bufoff, gbase, voff) do { _Pragma("unroll") for (int _i = 0; _i < 2; ++_i) \
        __builtin_amdgcn_global_load_lds((const unsigned*)((const char*)(gbase) + (voff)[_i]), (PG8_LAS unsigned*)(lds + (bufoff) + ldsw + _i * 8192), 16, 0, 0); } while (0)
#define PG8_LDA(dst, b, h) do { _Pragma("unroll") for (int m = 0; m < 4; ++m) _Pragma("unroll") for (int k = 0; k < 2; ++k) dst[m][k] = *(const PG8_LAS bf16x8*)(lds + PG8_SA(b, h) + aoff + m * 2048 + k * 1024); } while (0)
#define PG8_LDB(dst, b, h) do { _Pragma("unroll") for (int n = 0; n < 2; ++n) _Pragma("unroll") for (int k = 0; k < 2; ++k) dst[n][k] = *(const PG8_LAS bf16x8*)(lds + PG8_SB(b, h) + boff + n * 2048 + k * 1024); } while (0)
#define PG8_MMA(ai, bj, At, Bt) do { __builtin_amdgcn_s_setprio(1); _Pragma("unroll") for (int m = 0; m < 4; ++m) _Pragma("unroll") for (int n = 0; n < 2; ++n) _Pragma("unroll") for (int k = 0; k < 2; ++k) \
        acc[ai][bj][m][n] = __builtin_amdgcn_mfma_f32_16x16x32_bf16(Bt[n][k], At[m][k], acc[ai][bj][m][n], 0, 0, 0); __builtin_amdgcn_s_setprio(0); } while (0)
#define PG8_WAIT_V(n) asm volatile("s_waitcnt vmcnt(" #n ")" ::: "memory")
#define PG8_WAIT_L(n) asm volatile("s_waitcnt lgkmcnt(" #n ")" ::: "memory")
#define PG8_BAR __builtin_amdgcn_s_barrier()
#define PG8_SCHED __builtin_amdgcn_sched_barrier(0)
    Unit cur, nxt; int ui = 0;
    if (!S.next(0, cur)) return;
    f32x4 acc[2][2][4][2];
#pragma unroll
    for (int a = 0; a < 2; ++a)
#pragma unroll
        for (int b = 0; b < 2; ++b)
#pragma unroll
            for (int m = 0; m < 4; ++m)
#pragma unroll
                for (int n = 0; n < 2; ++n) acc[a][b][m][n] = (f32x4){0.f, 0.f, 0.f, 0.f};
    bf16x8 At[4][2], B0[2][2], B1[2][2];
    const char* cA = (const char*)g.A + (size_t)cur.pm * tstep; const char* cB = (const char*)g.Bt + (size_t)cur.pn * tstep;
    S.a_ready(cur);
    if constexpr (SP2) {
        PG8_STAGE(PG8_SB(0, 0), cB, voffB); PG8_STAGE(PG8_SB(0, 1), cB + hstep, voffB); PG8_STAGE(PG8_SA(0, 0), cA, voffA); PG8_STAGE(PG8_SA(0, 1), cA + hstep, voffA);
        if (wr == 1) PG8_BAR;
        PG8_WAIT_V(2); PG8_BAR;
        PG8_STAGE(PG8_SB(1, 0), cB + kstep, voffB); PG8_STAGE(PG8_SA(1, 0), cA + kstep, voffA); PG8_STAGE(PG8_SB(1, 1), cB + hstep + kstep, voffB);
        PG8_WAIT_V(6); PG8_BAR;
    } else {
        PG8_STAGE(PG8_SB(0, 0), cB, voffB); PG8_STAGE(PG8_SA(0, 0), cA, voffA); PG8_STAGE(PG8_SB(0, 1), cB + hstep, voffB); PG8_STAGE(PG8_SA(0, 1), cA + hstep, voffA);
        if (wr == 1) PG8_BAR;
        PG8_WAIT_V(4); PG8_BAR;
        PG8_STAGE(PG8_SB(1, 0), cB + kstep, voffB); PG8_STAGE(PG8_SA(1, 0), cA + kstep, voffA); PG8_STAGE(PG8_SB(1, 1), cB + hstep + kstep, voffB);
        PG8_WAIT_V(6); PG8_BAR;
    }
    for (;;) {
        const bool has_next = S.next(ui + 1, nxt);
        const char* nA = has_next ? (const char*)g.A + (size_t)nxt.pm * tstep : cA; const char* nB = has_next ? (const char*)g.Bt + (size_t)nxt.pn * tstep : cB;
        for (int t = 0; t < nt; t += 2) {
            const bool last = (t == nt - 2);
            if constexpr (MID) {
                PG8_LAS float* midl = (PG8_LAS float*)(lds + STAGE_BYTES + 2048);
                if (t == (nt >> 1) - 2) { if (tid < 256) { const f32x2 ms = *(const f32x2*)(mid_scale + 2 * (cur.pm * BM + tid)); midl[tid] = ms.x; midl[256 + tid] = ms.y; } }
                if (t == (nt >> 1)) { const PG8_LAS float* mp_ = midl + wr * 64 + fr;
#pragma unroll
                    for (int a_ = 0; a_ < 2; ++a_)
#pragma unroll
                        for (int m_ = 0; m_ < 4; ++m_) { const float rr = mp_[a_ * HALF + m_ * 16];
#pragma unroll
                            for (int b_ = 0; b_ < 2; ++b_)
#pragma unroll
                                for (int n_ = 0; n_ < 2; ++n_) acc[a_][b_][m_][n_] = acc[a_][b_][m_][n_] * rr; } } }
            const char* a1 = cA + (size_t)(t + 1) * kstep;
            const char* a2 = last ? nA : cA + (size_t)(t + 2) * kstep; const char* b2 = last ? nB : cB + (size_t)(t + 2) * kstep;
            const char* a3 = a2 + kstep; const char* b3 = b2 + kstep;
            if (last && has_next) S.a_ready(nxt);
            if constexpr (SP2) {
            PG8_LDB(B0, 0, 0); PG8_LDB(B1, 0, 1); PG8_SCHED; PG8_LDA(At, 0, 0); PG8_STAGE(PG8_SA(1, 1), a1 + hstep, voffA);
            PG8_WAIT_V(8); PG8_WAIT_L(0); PG8_BAR; PG8_MMA(0, 0, At, B0); PG8_MMA(0, 1, At, B1); PG8_BAR; PG8_SCHED;
            PG8_LDA(At, 0, 1); PG8_STAGE(PG8_SB(0, 0), b2, voffB); PG8_STAGE(PG8_SB(0, 1), b2 + hstep, voffB); PG8_STAGE(PG8_SA(0, 0), a2, voffA);
            PG8_WAIT_V(8); PG8_WAIT_L(0); PG8_BAR; PG8_MMA(1, 0, At, B0); PG8_MMA(1, 1, At, B1); PG8_BAR; PG8_SCHED;
            PG8_LDB(B0, 1, 0); PG8_LDB(B1, 1, 1); PG8_SCHED; PG8_LDA(At, 1, 0); PG8_STAGE(PG8_SA(0, 1), a2 + hstep, voffA);
            PG8_WAIT_V(8); PG8_WAIT_L(0); PG8_BAR; PG8_MMA(0, 0, At, B0); PG8_MMA(0, 1, At, B1); PG8_BAR; PG8_SCHED;
            PG8_LDA(At, 1, 1); PG8_STAGE(PG8_SB(1, 0), b3, voffB); PG8_STAGE(PG8_SB(1, 1), b3 + hstep, voffB); PG8_STAGE(PG8_SA(1, 0), a3, voffA);
            PG8_WAIT_V(8); PG8_WAIT_L(0); PG8_BAR; PG8_MMA(1, 0, At, B0); PG8_MMA(1, 1, At, B1); PG8_BAR; PG8_SCHED;
            } else {
            PG8_LDB(B0, 0, 0); PG8_SCHED; PG8_LDA(At, 0, 0); PG8_STAGE(PG8_SA(1, 1), a1 + hstep, voffA);
            PG8_WAIT_L(8); PG8_BAR; PG8_WAIT_L(0); PG8_MMA(0, 0, At, B0); PG8_BAR; PG8_SCHED;
            PG8_LDB(B1, 0, 1); PG8_STAGE(PG8_SB(0, 0), b2, voffB);
            PG8_BAR; PG8_WAIT_L(0); PG8_MMA(0, 1, At, B1); PG8_BAR;
            PG8_LDA(At, 0, 1); PG8_STAGE(PG8_SA(0, 0), a2, voffA);
            PG8_BAR; PG8_WAIT_L(0); PG8_MMA(1, 0, At, B0); PG8_BAR; PG8_SCHED;
            PG8_STAGE(PG8_SB(0, 1), b2 + hstep, voffB);
            PG8_WAIT_V(6); PG8_BAR; PG8_MMA(1, 1, At, B1); PG8_BAR;
            PG8_LDB(B0, 1, 0); PG8_SCHED; PG8_LDA(At, 1, 0); PG8_STAGE(PG8_SA(0, 1), a2 + hstep, voffA);
            PG8_WAIT_L(8); PG8_BAR; PG8_WAIT_L(0); PG8_MMA(0, 0, At, B0); PG8_BAR; PG8_SCHED;
            PG8_LDB(B1, 1, 1); PG8_STAGE(PG8_SB(1, 0), b3, voffB);
            PG8_BAR; PG8_WAIT_L(0); PG8_MMA(0, 1, At, B1); PG8_BAR;
            PG8_LDA(At, 1, 1); PG8_STAGE(PG8_SA(1, 0), a3, voffA);
            PG8_BAR; PG8_WAIT_L(0); PG8_MMA(1, 0, At, B0); PG8_BAR; PG8_SCHED;
            PG8_STAGE(PG8_SB(1, 1), b3 + hstep, voffB);
            PG8_WAIT_V(6); PG8_BAR; PG8_MMA(1, 1, At, B1); PG8_BAR;
            }
        }
        if constexpr (ALIGN_EPI) { if (wr == 0) PG8_BAR; }
        if constexpr (!Epi::AFTER_DRAIN) { E(acc, cur, wr, wc, fr, fq); S.done(cur); }
        if (!has_next) break;
#pragma unroll
        for (int a = 0; a < 2; ++a)
#pragma unroll
            for (int b = 0; b < 2; ++b)
#pragma unroll
                for (int m = 0; m < 4; ++m)
#pragma unroll
                    for (int n = 0; n < 2; ++n) acc[a][b][m][n] = (f32x4){0.f, 0.f, 0.f, 0.f};
        cur = nxt; cA = nA; cB = nB; ++ui;
        if constexpr (ALIGN_EPI) { if (wr == 1) PG8_BAR; }
    }
    PG8_WAIT_V(0);
    if constexpr (!ALIGN_EPI) { if (wr == 0) PG8_BAR; }
    PG8_BAR;
    if constexpr (Epi::AFTER_DRAIN) { E.fused(acc, cur, wr, wc, fr, fq, lds, wid, lane); S.done(cur); }
#undef PG8_SA
#undef PG8_SB
#undef PG8_STAGE
#undef PG8_LDA
#undef PG8_LDB
#undef PG8_MMA
#undef PG8_WAIT_V
#undef PG8_WAIT_L
#undef PG8_BAR
#undef PG8_SCHED
}
}

namespace mixp {
using pg8::bf16_t; using pg8::bf16x8; using pg8::f32x4; using pg8::u32x4; using pg8::MTOK; using pg8::VPITCH; using pg8::NORM_EPS;
typedef float f32x16 __attribute__((ext_vector_type(16)));
typedef short s16x4 __attribute__((ext_vector_type(4)));
typedef unsigned u32x2 __attribute__((ext_vector_type(2)));
typedef float f32x2_t __attribute__((ext_vector_type(2))); typedef __bf16 bf16x2_t __attribute__((ext_vector_type(2)));
#define MX_LAS __attribute__((address_space(3)))
#define MFMA32(a, b, c) __builtin_amdgcn_mfma_f32_32x32x16_bf16((a), (b), (c), 0, 0, 0)
__device__ __forceinline__ unsigned cvtpk(float lo, float hi) { f32x2_t v = {lo, hi}; bf16x2_t b = __builtin_convertvector(v, bf16x2_t); return __builtin_bit_cast(unsigned, b); }
__device__ __forceinline__ float bf2f(short s) { return __uint_as_float(((unsigned)(unsigned short)s) << 16); }
__device__ __forceinline__ float half_sum(float v) { auto rr = __builtin_amdgcn_permlane32_swap(__float_as_uint(v), __float_as_uint(v), false, false); return __uint_as_float(rr[0]) + __uint_as_float(rr[1]); }

struct MixArgs { const bf16_t *Q, *K, *U, *Vt, *Gt, *Wsb; const float *gss, *bsp, *sgn, *gA, *gB; bf16_t* mixed; float* rowsc; };

__device__ __forceinline__ void mix_phase(MX_LAS unsigned char* lds, const MixArgs& a, int G, int bid) {
    const int tid = threadIdx.x, lane = tid & 63, l32 = lane & 31, hi = lane >> 5;
    const int w = __builtin_amdgcn_readfirstlane(tid >> 6);
    MX_LAS bf16x8* gnl = (MX_LAS bf16x8*)(lds + w * 16384) + lane;
    MX_LAS float* rgs = (MX_LAS float*)(lds + 131072 + 512);
    MX_LAS float* rtab = (MX_LAS float*)(lds + 131072 + 1024);
    MX_LAS float* part = (MX_LAS float*)(lds + 131072 + 2048);
    MX_LAS float* gtab = (MX_LAS float*)(lds + 131072 + 10240);
    const f32x16 zero16 = {0.f, 0.f, 0.f, 0.f, 0.f, 0.f, 0.f, 0.f, 0.f, 0.f, 0.f, 0.f, 0.f, 0.f, 0.f, 0.f};
    { gtab[tid] = a.gA[tid]; gtab[512 + tid] = a.gB[tid]; }
    const MX_LAS float* gl = gtab + 64 * w + 4 * hi;
    const int vcu = (G % 8 == 0) ? (bid % 8) * (G / 8) + bid / 8 : bid;
    for (int unit = vcu; unit < MTOK / 128; unit += G) {
        const int tok0 = unit * 128;
        const int s0 = (unit & 63) * 128;
        const size_t seq0 = (size_t)(unit >> 6) * 8192;
        if (tid < 128) { const int t = tok0 + tid; const float s = (a.gss[t] + a.gss[MTOK + t]) + (a.gss[2 * MTOK + t] + a.gss[3 * MTOK + t]); rgs[tid] = __builtin_amdgcn_rsqf(s * (1.0f / 512.0f) + NORM_EPS); }
        __syncthreads();
#pragma unroll
        for (int cb = 0; cb < 2; ++cb) { const int c = 64 * w + 32 * cb + l32; const float sg = a.sgn[c]; const bf16_t* gp = a.Gt + (((size_t)unit * 8 + w) * 2 + cb) * 8 * 512 + (l32 * 2 + hi) * 8;
            bf16x8 raw[8];
#pragma unroll
            for (int kk = 0; kk < 8; ++kk) raw[kk] = *(const bf16x8*)(gp + kk * 512);
#pragma unroll
            for (int kk = 0; kk < 8; ++kk) {
                const f32x4 r0 = *(const MX_LAS f32x4*)(rgs + 16 * kk + 8 * hi) * sg, r1 = *(const MX_LAS f32x4*)(rgs + 16 * kk + 8 * hi + 4) * sg;
                u32x4 pk; pk.x = cvtpk(bf2f(raw[kk][0]) * r0[0], bf2f(raw[kk][1]) * r0[1]); pk.y = cvtpk(bf2f(raw[kk][2]) * r0[2], bf2f(raw[kk][3]) * r0[3]);
                pk.z = cvtpk(bf2f(raw[kk][4]) * r1[0], bf2f(raw[kk][5]) * r1[1]); pk.w = cvtpk(bf2f(raw[kk][6]) * r1[2], bf2f(raw[kk][7]) * r1[3]);
                gnl[(cb * 8 + kk) * 64] = __builtin_bit_cast(bf16x8, pk); } }
#define MX_STORE2(X, GP, COFF) do { _Pragma("unroll") for (int k = 0; k < 4; k += 2) { \
                const f32x4 g0 = *(const MX_LAS f32x4*)((GP) + 8 * k), g1 = *(const MX_LAS f32x4*)((GP) + 8 * k + 8); \
                unsigned ax = cvtpk(X[4 * k] * g0[0], X[4 * k + 1] * g0[1]), ay = cvtpk(X[4 * k + 2] * g0[2], X[4 * k + 3] * g0[3]); \
                unsigned bx_ = cvtpk(X[4 * k + 4] * g1[0], X[4 * k + 5] * g1[1]), by_ = cvtpk(X[4 * k + 6] * g1[2], X[4 * k + 7] * g1[3]); \
                auto rx = __builtin_amdgcn_permlane32_swap(ax, bx_, false, false); auto ry = __builtin_amdgcn_permlane32_swap(ay, by_, false, false); \
                u32x4 v; v.x = rx[0]; v.y = ry[0]; v.z = rx[1]; v.w = ry[1]; \
                *(u32x4*)(mp + (COFF) + 8 * k) = v; } } while (0)
        {
            bf16x8 wX[8], wY[8]; s16x4 uX0[4], uX1[4], uY0[4], uY1[4]; float bX, bY;
#define MX_SG_LOAD(ib_, W_, U0_, U1_, B_) do { \
                const bf16_t* wp = a.Wsb + (size_t)(w * 4 + (ib_)) * 8 * 512 + (l32 * 2 + hi) * 8; _Pragma("unroll") for (int kk = 0; kk < 8; ++kk) W_[kk] = *(const bf16x8*)(wp + kk * 512); \
                const bf16_t* up = a.U + ((size_t)((tok0 >> 5) + (ib_)) * 8 + w) * 4 * 512 + (l32 * 2 + hi) * 8; \
                _Pragma("unroll") for (int q = 0; q < 2; ++q) { const bf16x8 ua = *(const bf16x8*)(up + q * 512), ub = *(const bf16x8*)(up + (2 + q) * 512); \
                    U0_[2 * q] = __builtin_shufflevector(ua, ua, 0, 1, 2, 3); U0_[2 * q + 1] = __builtin_shufflevector(ua, ua, 4, 5, 6, 7); U1_[2 * q] = __builtin_shufflevector(ub, ub, 0, 1, 2, 3); U1_[2 * q + 1] = __builtin_shufflevector(ub, ub, 4, 5, 6, 7); } \
                B_ = a.bsp[w * 128 + 32 * (ib_) + l32]; } while (0)
#define MX_SG_RUN(ib_, W_, U0_, U1_, B_) do { f32x16 sg0 = zero16, sg1 = zero16; \
                _Pragma("unroll") for (int kk = 0; kk < 8; ++kk) { sg0 = MFMA32(gnl[kk * 64], W_[kk], sg0); sg1 = MFMA32(gnl[(8 + kk) * 64], W_[kk], sg1); }     \
                float pb = 0.f; \
                _Pragma("unroll") for (int g4 = 0; g4 < 4; ++g4) _Pragma("unroll") for (int e = 0; e < 4; ++e) { \
                    sg0[4 * g4 + e] = bf2f(U0_[g4][e]) * (sg0[4 * g4 + e] + B_); sg1[4 * g4 + e] = bf2f(U1_[g4][e]) * (sg1[4 * g4 + e] + B_); \
                    pb += sg0[4 * g4 + e] * sg0[4 * g4 + e] + sg1[4 * g4 + e] * sg1[4 * g4 + e]; } \
                pb = half_sum(pb); if (hi == 0) part[(32 * (ib_) + l32) * 16 + 8 + w] = pb; \
                bf16_t* mp = a.mixed + (size_t)(tok0 + 32 * (ib_) + l32) * 1024 + 64 * w + 8 * hi; \
                MX_STORE2(sg0, (gl + 512), 512); MX_STORE2(sg1, (gl + 512 + 32), 512 + 32); } while (0)
            MX_SG_LOAD(0, wX, uX0, uX1, bX); MX_SG_LOAD(1, wY, uY0, uY1, bY);
            MX_SG_RUN(0, wX, uX0, uX1, bX); MX_SG_LOAD(2, wX, uX0, uX1, bX);
            MX_SG_RUN(1, wY, uY0, uY1, bY); MX_SG_LOAD(3, wY, uY0, uY1, bY);
            MX_SG_RUN(2, wX, uX0, uX1, bX);
            MX_SG_RUN(3, wY, uY0, uY1, bY);
#undef MX_SG_LOAD
#undef MX_SG_RUN
        }
        const bf16_t* Kw = a.K + (size_t)w * 4 * 512 + (l32 * 2 + hi) * 8;
        const bf16_t* vrow = a.Vt + (size_t)w * 4 * 512 + (l32 * 2 + hi) * 8;
#define MX_LOADKV(kf, va, k0_) do { const int kc_ = (k0_) < 0 ? 0 : (k0_); const size_t tb_ = ((seq0 + (size_t)kc_) >> 5) * 16384; const bf16_t* kp_ = Kw + tb_; const bf16_t* vp_ = vrow + tb_; \
            _Pragma("unroll") for (int kk = 0; kk < 4; ++kk) kf[kk] = *(const bf16x8*)(kp_ + kk * 512); \
            _Pragma("unroll") for (int db = 0; db < 2; ++db) _Pragma("unroll") for (int s = 0; s < 2; ++s) va[db][s] = *(const bf16x8*)(vp_ + (2 * db + s) * 512); } while (0)
#define MX_VF(va, db, s) va[db][s]
#define MX_TILE(kf, va, DIAG) do { \
            f32x16 S = zero16; \
            _Pragma("unroll") for (int kk = 0; kk < 4; ++kk) S = MFMA32(kf[kk], qf[kk], S); \
            f32x4 f4[4], be4[4];                                    \
            _Pragma("unroll") for (int g = 0; g < 4; ++g) { \
                const f32x4 sv = {S[4 * g], S[4 * g + 1], S[4 * g + 2], S[4 * g + 3]}; \
                const f32x4 e4 = pg8::exp2_4(sv); f4[g] = pg8::rcp_4(e4 + 1.0f); be4[g] = 1.0f - f4[g]; }     \
            if (DIAG) { _Pragma("unroll") for (int g = 0; g < 4; ++g) _Pragma("unroll") for (int e = 0; e < 4; ++e) { const int key = e + 8 * g + 4 * hi; if (key >= l32) { f4[g][e] = 1.f; be4[g][e] = 0.f; } } } \
            f32x4 c4[4]; float T[4]; \
            _Pragma("unroll") for (int g = 0; g < 4; ++g) { const float p2 = f4[g][3], p1 = p2 * f4[g][2], p0 = p1 * f4[g][1]; T[g] = p0 * f4[g][0]; c4[g] = (f32x4){p0, p1, p2, 1.f}; } \
            float Ta[4], Tb[4]; \
            _Pragma("unroll") for (int g = 0; g < 4; ++g) { auto rr = __builtin_amdgcn_permlane32_swap(__float_as_uint(T[g]), __float_as_uint(T[g]), false, false); Ta[g] = __uint_as_float(rr[0]); Tb[g] = __uint_as_float(rr[1]); } \
            const float E6 = Tb[3], E5 = E6 * Ta[3], E4 = E5 * Tb[2], E3 = E4 * Ta[2], E2 = E3 * Tb[1], E1 = E2 * Ta[1], E0 = E1 * Tb[0], total = E0 * Ta[0]; \
            float Eg[4]; Eg[0] = hi ? E1 : E0; Eg[1] = hi ? E3 : E2; Eg[2] = hi ? E5 : E4; Eg[3] = hi ? 1.f : E6; \
            f32x4 A4[4]; \
            _Pragma("unroll") for (int g = 0; g < 4; ++g) A4[g] = be4[g] * (c4[g] * (carry * Eg[g])); \
            carry *= total; \
            u32x4 w0, w1; \
            w0.x = cvtpk(A4[0][0], A4[0][1]); w0.y = cvtpk(A4[0][2], A4[0][3]); w0.z = cvtpk(A4[1][0], A4[1][1]); w0.w = cvtpk(A4[1][2], A4[1][3]); \
            w1.x = cvtpk(A4[2][0], A4[2][1]); w1.y = cvtpk(A4[2][2], A4[2][3]); w1.z = cvtpk(A4[3][0], A4[3][1]); w1.w = cvtpk(A4[3][2], A4[3][3]); \
            const bf16x8 ps0 = __builtin_bit_cast(bf16x8, w0), ps1 = __builtin_bit_cast(bf16x8, w1); \
            o0 = MFMA32(MX_VF(va, 0, 0), ps0, o0); o0 = MFMA32(MX_VF(va, 0, 1), ps1, o0); \
            o1 = MFMA32(MX_VF(va, 1, 0), ps0, o1); o1 = MFMA32(MX_VF(va, 1, 1), ps1, o1); } while (0)
        bf16x8 qf[4], kfA[4], kfB[4], kfC[4], vaA[2][2], vaB[2][2], vaC[2][2];
#define MX_PRELOAD(ib_) do { const int q0_ = s0 + 32 * (ib_); \
            { const bf16_t* qp = a.Q + ((seq0 + (size_t)q0_) >> 5) * 16384 + (size_t)w * 4 * 512 + (l32 * 2 + hi) * 8; _Pragma("unroll") for (int kk = 0; kk < 4; ++kk) qf[kk] = *(const bf16x8*)(qp + kk * 512); } \
            MX_LOADKV(kfA, vaA, q0_); MX_LOADKV(kfB, vaB, q0_ - 32); } while (0)
        MX_PRELOAD(0);
#pragma unroll 1
        for (int ib = 0; ib < 4; ++ib) {
            const int q0 = s0 + 32 * ib;
            f32x16 o0 = zero16, o1 = zero16;
            {
                float carry = 1.f; int k0 = q0;
                for (;;) {
                    MX_LOADKV(kfC, vaC, k0 - 64);
                    MX_TILE(kfA, vaA, k0 == q0);
                    if (k0 < 32 || !__any(carry >= 1e-37f)) break;
                    k0 -= 32;
                    MX_LOADKV(kfA, vaA, k0 - 64);
                    MX_TILE(kfB, vaB, false);
                    if (k0 < 32 || !__any(carry >= 1e-37f)) break;
                    k0 -= 32;
                    MX_LOADKV(kfB, vaB, k0 - 64);
                    MX_TILE(kfC, vaC, false);
                    if (k0 < 32 || !__any(carry >= 1e-37f)) break;
                    k0 -= 32;
                }
            }
            float pa = 0.f;
#pragma unroll
            for (int r = 0; r < 16; ++r) pa += o0[r] * o0[r] + o1[r] * o1[r];
            pa = half_sum(pa); if (hi == 0) part[(32 * ib + l32) * 16 + w] = pa;
            if (ib < 3) MX_PRELOAD(ib + 1);
            bf16_t* mp = a.mixed + (size_t)(tok0 + 32 * ib + l32) * 1024 + 64 * w + 8 * hi;
            MX_STORE2(o0, gl, 0); MX_STORE2(o1, (gl + 32), 32);
        }
#undef MX_STORE2
#undef MX_LOADKV
#undef MX_PRELOAD
#undef MX_VF
#undef MX_TILE
        __syncthreads();
        if (tid < 128) { const MX_LAS f32x4* pp = (const MX_LAS f32x4*)(part + tid * 16); const f32x4 pa4 = pp[0] + pp[1], pb4 = pp[2] + pp[3];
            const float rA = __builtin_amdgcn_rsqf(((pa4[0] + pa4[1]) + (pa4[2] + pa4[3])) * (1.0f / 512.0f) + NORM_EPS), rB = __builtin_amdgcn_rsqf(((pb4[0] + pb4[1]) + (pb4[2] + pb4[3])) * (1.0f / 512.0f) + NORM_EPS);
            f32x2_t o; o.x = rA / rB; o.y = rB; *(f32x2_t*)(a.rowsc + (size_t)(tok0 + tid) * 2) = o; }
    }
}
#undef MFMA32
}

#ifndef MK_N_LAUNCHES
#define MK_N_LAUNCHES 1
#endif
constexpr int NWAVES = 8;
constexpr int MTOK = pg8::MTOK, DM = 1024, NTOK1 = 1536, NCH1 = 1024, DFF = 2816, NGU = 2 * DFF;
constexpr size_t MiB = 1u << 20;
constexpr size_t WS_WTOK = 2 * MiB, WS_WCH = 5 * MiB, WS_WOUT = 7 * MiB, WS_WGU = 9 * MiB, WS_WDN = 20 * MiB, WS_WSB = 26 * MiB, WS_RSTD1 = 27 * MiB, WS_RSTD2 = 27 * MiB + 512 * 1024, WS_GSS = 28 * MiB, WS_SS2 = 29 * MiB, WS_ROWSC = 33 * MiB;
constexpr size_t WS_XB = 64 * MiB, WS_Q = 192 * MiB, WS_K = 256 * MiB, WS_U = 320 * MiB, WS_VT = 384 * MiB, WS_GT = 452 * MiB, WS_MIXED = 520 * MiB, WS_X1B = 648 * MiB, WS_END = 776 * MiB;
constexpr size_t WS_ACT = 64 * MiB;
static_assert(WS_K - WS_Q == WS_U - WS_K, "q | k | u outputs equally spaced");
static_assert(WS_VT + (size_t)512 * pg8::VPITCH * 2 <= WS_GT && WS_GT + (size_t)512 * pg8::VPITCH * 2 <= WS_MIXED, "V^T / G^T slots");
static_assert(WS_WGU + (size_t)NGU * DM * 2 <= WS_WDN && WS_WDN + (size_t)DM * DFF * 2 <= WS_WSB && WS_SS2 + (size_t)MTOK * 64 <= WS_XB && WS_ACT + (size_t)MTOK * DFF * 2 <= WS_MIXED, "d_ws map");
constexpr int RING_BYTES = 131072;
constexpr int LDS_BYTES = 147456;

#define GAS __attribute__((address_space(1)))
#define LAS __attribute__((address_space(3)))
typedef unsigned short bf16;
typedef unsigned v4u __attribute__((ext_vector_type(4)));
typedef float f32x4 __attribute__((ext_vector_type(4)));
#define LDS_WAIT() asm volatile("s_waitcnt lgkmcnt(0)" ::: "memory")
__device__ __forceinline__ unsigned f2bf(float f) { unsigned u = __builtin_bit_cast(unsigned, f); return (u + 0x7fffu + ((u >> 16) & 1u)) >> 16; }
__device__ __forceinline__ unsigned pk2(float lo, float hi) { return f2bf(lo) | (f2bf(hi) << 16); }
__device__ __forceinline__ float wave_sum(float v) {
#pragma unroll
    for (int o = 1; o < 64; o <<= 1) v += __shfl_xor(v, o);
    return v;
}
__device__ __forceinline__ void tr_item(const float* W, int ldw, int k0, int n_src0, const float* scale, bf16* WT, int ldt, int n_dst0, int n_dst1, LAS float* scr, int lane) {
    const int rr = lane >> 4, cc = 4 * (lane & 15);
    f32x4 v[16]; float sc[16];
#pragma unroll
    for (int i = 0; i < 16; ++i) { v[i] = *(const f32x4*)(W + (size_t)(k0 + 4 * i + rr) * ldw + n_src0 + cc); sc[i] = scale ? scale[k0 + 4 * i + rr] : 1.0f; }
#pragma unroll
    for (int i = 0; i < 16; ++i) { const int kk = 4 * i + rr; LAS float* row = scr + kk * 64;
        row[(cc + kk) & 63] = v[i].x * sc[i]; row[(cc + 1 + kk) & 63] = v[i].y * sc[i]; row[(cc + 2 + kk) & 63] = v[i].z * sc[i]; row[(cc + 3 + kk) & 63] = v[i].w * sc[i]; }
    LDS_WAIT(); asm volatile("" ::: "memory");
    const int c = lane & 7;
#pragma unroll
    for (int j = 0; j < 8; ++j) { const int n = (lane >> 3) + 8 * j; float e[8];
#pragma unroll
        for (int q = 0; q < 8; ++q) { const int kk = 8 * c + q; e[q] = scr[kk * 64 + ((n + kk) & 63)]; }
        v4u o; o.x = pk2(e[0], e[1]); o.y = pk2(e[2], e[3]); o.z = pk2(e[4], e[5]); o.w = pk2(e[6], e[7]);
        *(v4u*)(WT + (size_t)((n < 32 ? n_dst0 : n_dst1 - 32) + n) * ldt + k0 + 8 * c) = o; }
    LDS_WAIT(); asm volatile("" ::: "memory");
}

#define RLX_AGENT __ATOMIC_RELAXED, __HIP_MEMORY_SCOPE_AGENT
#define XB_TMO      128
#define XB_XCNT(j)  (256  + 64 * (j))
#define XB_XSUB(j)  (1280 + 64 * (j))
#define XB_XGEN(j)  (2304 + 64 * (j))
#define XB_TOP      3328
#define XB_TOPGEN   3392
#define XCD_BAR_WORDS 3456
#define XB_SPIN_CAP (1u << 18)

__device__ __forceinline__ unsigned xb_ld(unsigned* p)              { return __hip_atomic_load(p, __ATOMIC_RELAXED, __HIP_MEMORY_SCOPE_AGENT); }
__device__ __forceinline__ unsigned xb_add(unsigned* p, unsigned v) { return __hip_atomic_fetch_add(p, v, __ATOMIC_RELAXED, __HIP_MEMORY_SCOPE_AGENT); }
__device__ __forceinline__ unsigned xb_xcc_id() { return (unsigned)__builtin_amdgcn_s_getreg((3 << 11) | 20) & 0xFu; }
#define XB_SPIN(cond, bar) do { unsigned _sp = 0; while (cond) { __builtin_amdgcn_s_sleep(1); \
    if ((++_sp & 255u) == 0u) { if (xb_ld(&(bar)[XB_TMO])) break; if (_sp > XB_SPIN_CAP) { atomicAdd(&(bar)[XB_TMO], 1u); break; } } } } while (0)

struct XcdBarrier {
    unsigned* bar; unsigned x;
    volatile LAS unsigned* st;
};

__device__ __forceinline__ XcdBarrier xcd_barrier_post(unsigned* bar, volatile LAS unsigned* st) {
    XcdBarrier b; b.bar = bar; b.x = xb_xcc_id(); b.st = st;
    if (threadIdx.x == 0) (void)xb_add(&bar[XB_XCNT(b.x)], 1u);
    return b;
}
__device__ __forceinline__ void xcd_barrier_complete(unsigned* bar, unsigned x, unsigned& nloc, unsigned& nx) {
    const unsigned G = gridDim.x * gridDim.y * gridDim.z;
    unsigned sum, cnt, mine, sp = 0u;
    for (;;) {
        sum = 0u; cnt = 0u; mine = 0u;
#pragma unroll
        for (unsigned j = 0; j < 16; ++j) { const unsigned c = xb_ld(&bar[XB_XCNT(j)]); sum += c; cnt += (c > 0u) ? 1u : 0u; mine = (j == x) ? c : mine; }
        if (sum == G) break;
        __builtin_amdgcn_s_sleep(1);
        if ((++sp & 255u) == 0u) { if (xb_ld(&bar[XB_TMO])) break; if (sp > XB_SPIN_CAP) { atomicAdd(&bar[XB_TMO], 1u); break; } }
    }
    nloc = mine > 0u ? mine : 1u; nx = cnt > 0u ? cnt : 1u;
}

__device__ __forceinline__ void xcd_barrier(const XcdBarrier& b) {
    asm volatile("s_waitcnt vmcnt(0)" ::: "memory");
    __syncthreads();
    if (threadIdx.x == 0) {
        unsigned* bar = b.bar;
        __builtin_amdgcn_s_waitcnt(0);
        unsigned nloc = b.st[0], nx = b.st[1];
        if (nloc == 0u) { xcd_barrier_complete(bar, b.x, nloc, nx); b.st[0] = nloc; b.st[1] = nx; }
        const unsigned old = xb_add(&bar[XB_XSUB(b.x)], 1u);
        const unsigned gen = old / nloc;
        if (old + 1u == (gen + 1u) * nloc) {
            __builtin_amdgcn_fence(__ATOMIC_RELEASE, "agent");
            asm volatile("s_waitcnt vmcnt(0)" ::: "memory");
            const unsigned og = xb_add(&bar[XB_TOP], 1u);
            const unsigned tg = og / nx;
            if (og + 1u == (tg + 1u) * nx) xb_add(&bar[XB_TOPGEN], 1u);
            else XB_SPIN(xb_ld(&bar[XB_TOPGEN]) == tg, bar);
            __builtin_amdgcn_fence(__ATOMIC_ACQUIRE, "agent");
            xb_add(&bar[XB_XGEN(b.x)], 1u);
            asm volatile("s_waitcnt vmcnt(0)" ::: "memory");
        } else {
            XB_SPIN(xb_ld(&bar[XB_XGEN(b.x)]) == gen, bar);
            __builtin_amdgcn_fence(__ATOMIC_ACQUIRE, "agent");
            asm volatile("s_waitcnt vmcnt(0)" ::: "memory");
        }
    }
    __syncthreads();
}

struct Args { const float* in[15]; float* out; unsigned char* ws; int ph_lo, ph_hi; };

__global__ void __launch_bounds__(NWAVES * 64, 2) fused_fwd(Args args) {
    extern __shared__ __attribute__((aligned(16))) unsigned char lds_raw[];
    LAS unsigned char* lds = (LAS unsigned char*)lds_raw;
    cg::grid_group grid = cg::this_grid();
    const int tid = threadIdx.x, lane = tid & 63, wave = __builtin_amdgcn_readfirstlane(tid >> 6);
    const int G = gridDim.x, bx = blockIdx.x;
    unsigned char* ws = args.ws;
    const float* x = args.in[0]; const float* attn_g = args.in[1]; const float* w_in = args.in[2]; const float* q_g = args.in[3]; const float* k_g = args.in[4]; const float* sgu_g = args.in[5];
    const float* w_sp = args.in[6]; const float* b_sp = args.in[7]; const float* sbo_g = args.in[8]; const float* sguo_g = args.in[9]; const float* w_out = args.in[10]; const float* ffn_g = args.in[11];
    const float* w_gate = args.in[12]; const float* w_up = args.in[13]; const float* w_down = args.in[14];
    bf16* Wtok = (bf16*)(ws + WS_WTOK); bf16* Wch = (bf16*)(ws + WS_WCH); bf16* Wout = (bf16*)(ws + WS_WOUT); bf16* Wgu = (bf16*)(ws + WS_WGU); bf16* Wdn = (bf16*)(ws + WS_WDN); bf16* Wsb = (bf16*)(ws + WS_WSB);
    float* rstd1 = (float*)(ws + WS_RSTD1); float* rstd2 = (float*)(ws + WS_RSTD2); float* rowsc = (float*)(ws + WS_ROWSC); float* gss = (float*)(ws + WS_GSS); float* ss2 = (float*)(ws + WS_SS2);
    bf16* XB = (bf16*)(ws + WS_XB); bf16* Qb = (bf16*)(ws + WS_Q); bf16* Kb = (bf16*)(ws + WS_K); bf16* Ub = (bf16*)(ws + WS_U); bf16* Vt = (bf16*)(ws + WS_VT); bf16* Gt = (bf16*)(ws + WS_GT);
    bf16* MIXED = (bf16*)(ws + WS_MIXED); bf16* X1B = (bf16*)(ws + WS_X1B); bf16* ACT = (bf16*)(ws + WS_ACT);
    const int lo = args.ph_lo, hi = args.ph_hi;
    for (int u = tid; u < (LDS_BYTES - RING_BYTES) / 4; u += NWAVES * 64) ((LAS unsigned*)(lds + RING_BYTES))[u] = 0u;
    __syncthreads();
    XcdBarrier bar; bar.bar = (unsigned*)ws; bar.x = 0; bar.st = nullptr;
    if (hi - lo > 1) bar = xcd_barrier_post((unsigned*)ws, (volatile LAS unsigned*)(lds + RING_BYTES + 352));
#define IN(k) (lo <= (k) && (k) < hi)
#define SEAM(k) do { if (IN(k) && IN((k) + 1)) { if (lo < 0) grid.sync();   else xcd_barrier(bar); } } while (0)

    if (IN(0)) {
        LAS float* scr = (LAS float*)(lds + wave * 16384);
        const int gw = bx * NWAVES + wave, NGW = G * NWAVES;
        constexpr int I1 = 24 * 16, I2 = 16 * 16, I3 = 16 * 16, I4 = 44 * 16, I5 = 44 * 16, I6 = 16 * 44, NITEMS = I1 + I2 + I3 + I4 + I5 + I6;
        for (int it = gw; it < NITEMS; it += NGW) {
            int r = it;
            if (r < I1) { const int kb = r / 24, nb = r % 24, region = nb / 8, cp = nb % 8;
                const int src = (region == 0 ? 0 : (region == 1 ? 512 : 1536)) + 64 * cp;
                const int dst = 512 * region + 256 * (cp / 4) + 32 * (cp % 4);
                tr_item(w_in, 2560, 64 * kb, src, attn_g, Wtok, DM, dst, dst + 128, scr, lane); continue; } r -= I1;
            if (r < I2) { const int kb = r / 16, nb = r % 16; const int src = (nb < 8 ? 1024 : 2048) + 64 * (nb % 8);
                tr_item(w_in, 2560, 64 * kb, src, attn_g, Wch, DM, 64 * nb, 64 * nb + 32, scr, lane); continue; } r -= I2;
            if (r < I3) { const int kb = r / 16, nb = r % 16; tr_item(w_out, DM, 64 * kb, 64 * nb, nullptr, Wout, DM, 64 * nb, 64 * nb + 32, scr, lane); continue; } r -= I3;
            if (r < I4) { const int kb = r / 44, nb = r % 44; const int dst = 256 * (nb / 2) + 64 * (nb % 2); tr_item(w_gate, DFF, 64 * kb, 64 * nb, ffn_g, Wgu, DM, dst, dst + 32, scr, lane); continue; } r -= I4;
            if (r < I5) { const int kb = r / 44, nb = r % 44; const int dst = 256 * (nb / 2) + 128 + 64 * (nb % 2); tr_item(w_up, DFF, 64 * kb, 64 * nb, ffn_g, Wgu, DM, dst, dst + 32, scr, lane); continue; } r -= I5;
            { const int kb = r / 16, nb = r % 16; tr_item(w_down, DM, 64 * kb, 64 * nb, nullptr, Wdn, DFF, 64 * nb, 64 * nb + 32, scr, lane); }
        }
        for (int i = bx * (NWAVES * 64) + tid; i < 8 * 128 * 128; i += G * NWAVES * 64) { const int ii = (i >> 7) & 127, jj = i & 127; Wsb[(((((i >> 14) * 4 + (ii >> 5)) * 8 + (jj >> 4)) * 32 + (ii & 31)) * 2 + ((jj >> 3) & 1)) * 8 + (jj & 7)] = (bf16)(((jj >> 6) <= (ii >> 6)) ? f2bf(w_sp[i]) : 0u); }
        for (int m0 = 4 * gw; m0 < MTOK; m0 += 4 * NGW) {
            f32x4 v[4][4]; float s[4];
#pragma unroll
            for (int q = 0; q < 4; ++q) { const f32x4* xr = (const f32x4*)(x + (size_t)(m0 + q) * DM) + lane;
#pragma unroll
                for (int j = 0; j < 4; ++j) v[q][j] = xr[64 * j]; }
#pragma unroll
            for (int q = 0; q < 4; ++q) { float t = 0.f;
#pragma unroll
                for (int j = 0; j < 4; ++j) t += (v[q][j].x * v[q][j].x + v[q][j].y * v[q][j].y) + (v[q][j].z * v[q][j].z + v[q][j].w * v[q][j].w);
                s[q] = wave_sum(t); }
            if (lane < 4) rstd1[m0 + lane] = __builtin_amdgcn_rsqf((lane == 0 ? s[0] : lane == 1 ? s[1] : lane == 2 ? s[2] : s[3]) * (1.0f / DM) + pg8::NORM_EPS);
#pragma unroll
            for (int q = 0; q < 4; ++q) { unsigned long long* o8 = (unsigned long long*)(XB + (size_t)(m0 + q) * DM) + lane;
#pragma unroll
                for (int j = 0; j < 4; ++j) o8[64 * j] = (unsigned long long)pk2(v[q][j].x, v[q][j].y) | ((unsigned long long)pk2(v[q][j].z, v[q][j].w) << 32); }
        }
    }
    SEAM(0);

    if (IN(1)) {
        { pg8::Gemm g{XB, Wtok, MTOK, NTOK1, DM}; pg8::StaticOrder S; S.init(MTOK, NTOK1, G, bx);
          pg8::EpiTok1 E{Qb, (size_t)(WS_K - WS_Q) / 2, rstd1, q_g, k_g};
          pg8::gemm_phase<pg8::EpiTok1, pg8::StaticOrder, true, true>(lds, g, S, E); }
        { pg8::Gemm g{Wch, XB, NCH1, MTOK, DM}; pg8::StaticOrder S; S.init(NCH1, MTOK, G, bx);
          pg8::EpiCh1 E{Vt, Gt, rstd1, gss};
          pg8::gemm_phase<pg8::EpiCh1, pg8::StaticOrder, true, true>(lds, g, S, E); }
    }
    SEAM(1);

    if (IN(2)) {
        const mixp::MixArgs ma{Qb, Kb, Ub, Vt, Gt, Wsb, gss, b_sp, sgu_g, sbo_g, sguo_g, MIXED, rowsc};
        mixp::mix_phase(lds, ma, G, bx);
    }
    SEAM(2);

    if (IN(3)) {
        pg8::Gemm g{MIXED, Wout, MTOK, DM, DM}; pg8::StaticOrder S; S.init(MTOK, DM, G, bx);
        pg8::EpiOut E{XB, X1B, ss2, (const LAS float*)(lds + pg8::STAGE_BYTES + 2048) + 256};
        pg8::gemm_phase<pg8::EpiOut, pg8::StaticOrder, true, true, true>(lds, g, S, E, rowsc);
    }
    SEAM(3);

    if (IN(4)) {
        pg8::Gemm g{X1B, Wgu, MTOK, NGU, DM}; pg8::StaticOrder S; S.init(MTOK, NGU, G, bx);
        pg8::gu_prepare_rstd(S, ss2, rstd2);
        pg8::EpiGU E{ACT, rstd2, DFF};
        pg8::gemm_phase<pg8::EpiGU, pg8::StaticOrder, true, true>(lds, g, S, E);
    }
    SEAM(4);

    if (IN(5)) {
        pg8::Gemm g{ACT, Wdn, MTOK, DM, DFF}; pg8::StaticOrder S; S.init(MTOK, DM, G, bx);
        pg8::EpiDown E{X1B, args.out};
        pg8::gemm_phase<pg8::EpiDown, pg8::StaticOrder, true, true>(lds, g, S, E);
    }
#undef IN
#undef SEAM
}

extern "C" void kernel_launch(void* const* d_in, const int* in_sizes, int n_in, void* d_out, int out_size, void* d_ws, size_t ws_size, hipStream_t stream) {
    static int grid = 0;
    if (grid == 0) {
        if (n_in != 15 || out_size != MTOK * DM || ws_size < WS_END) { fprintf(stderr, "kernel_launch: unexpected shapes (n_in %d, out %d, ws %zu)\n", n_in, out_size, ws_size); grid = -1; return; }
        int dev = 0, cus = 0, per_cu = 0;
        (void)hipGetDevice(&dev); (void)hipDeviceGetAttribute(&cus, hipDeviceAttributeMultiprocessorCount, dev);
        if (hipFuncSetAttribute((const void*)fused_fwd, hipFuncAttributeMaxDynamicSharedMemorySize, LDS_BYTES) != hipSuccess) { fprintf(stderr, "kernel_launch: hipFuncSetAttribute failed\n"); grid = -1; return; }
        if (hipOccupancyMaxActiveBlocksPerMultiprocessor(&per_cu, (const void*)fused_fwd, NWAVES * 64, LDS_BYTES) != hipSuccess || per_cu < 1) per_cu = 1;
        (void)hipGetLastError();
        grid = cus * per_cu;
    }
    if (grid < 0) return;
    if (hipMemsetAsync(d_ws, 0, 16384, stream) != hipSuccess) { fprintf(stderr, "kernel_launch: memset of the barrier words failed\n"); return; }
    Args a{};
    for (int i = 0; i < 15; ++i) a.in[i] = (const float*)d_in[i];
    a.out = (float*)d_out; a.ws = (unsigned char*)d_ws;
#if MK_N_LAUNCHES == 1
    a.ph_lo = 0; a.ph_hi = 6;
    void* params[] = {&a};
    const hipError_t e = hipLaunchCooperativeKernel((const void*)fused_fwd, dim3(grid), dim3(NWAVES * 64), params, LDS_BYTES, stream);
    if (e != hipSuccess) fprintf(stderr, "kernel_launch: cooperative launch failed: %s (grid %d)\n", hipGetErrorString(e), grid);
#else
    for (int p = 0; p < 6; ++p) { a.ph_lo = p; a.ph_hi = p + 1; hipLaunchKernelGGL(fused_fwd, dim3(grid), dim3(NWAVES * 64), LDS_BYTES, stream, a); }
#endif
}
```
